# Optimizing an MI355X kernel written in HIP

```python
import math
import jax, jax.numpy as jnp
from jax import lax
import numpy as np

D_MODEL = 2048
BATCH = 8
SEQ = 2048
DEPTH = 2

N_META = 16
BLOCK = 128
WINDOW = 128
HEAD_DIM = 64
A_HEADS = 8
A_KV_HEADS = 2
B_HEADS = 4
B_QK_DIM = 64
B_V_DIM = 2 * B_QK_DIM
C_HEADS = 8
IDX_HEADS = 8
IDX_DIM = 64
TOPK_MAX = 256
N_BUCKETS = 32
MAX_DISTANCE = 128
N_BIAS_HEADS = A_HEADS + B_HEADS + C_HEADS
N_BRANCH = 3
BRANCH_WIDTH = 512
D_FF = 5632
EPS = 1e-6
NEG = -1e30

IN_SPLITS = (
    A_HEADS * HEAD_DIM, A_KV_HEADS * HEAD_DIM, A_KV_HEADS * HEAD_DIM,
    B_HEADS * B_QK_DIM, B_HEADS * B_QK_DIM, B_HEADS * B_QK_DIM, B_HEADS * B_QK_DIM,
    B_HEADS * B_V_DIM,
    C_HEADS * HEAD_DIM, HEAD_DIM, HEAD_DIM,
    IDX_HEADS * IDX_DIM, IDX_DIM, IDX_HEADS,
    N_BRANCH * D_MODEL,
)
D_IN = sum(IN_SPLITS)

kernel_name = "hybrid_gated_swa_diff_dsa_macaron"


def rms_norm(x, g):
    xf = x.astype(jnp.float32)
    y = xf * lax.rsqrt(jnp.mean(xf * xf, axis=-1, keepdims=True) + EPS)
    return (y * g.astype(jnp.float32)).astype(x.dtype)


def swiglu(x, w_gate, w_up, w_down):
    return (jax.nn.silu(x @ w_gate) * (x @ w_up)) @ w_down


def rel_bucket(dist):
    max_exact = N_BUCKETS // 2
    d = jnp.maximum(dist, 0)
    df = jnp.maximum(d, 1).astype(jnp.float32)
    large = max_exact + (jnp.log(df / max_exact) / math.log(MAX_DISTANCE / max_exact)
                         * (N_BUCKETS - max_exact)).astype(jnp.int32)
    return jnp.where(d < max_exact, d, jnp.minimum(large, N_BUCKETS - 1))


def sliding_window_sink_attention(q, k, v, pos, sinks, table):
    bsz, P = q.shape[:2]
    nb = P // BLOCK
    grp = A_HEADS // A_KV_HEADS
    nk = N_META + 2 * BLOCK
    qb = q.reshape(bsz, nb, BLOCK, A_KV_HEADS, grp, HEAD_DIM)

    def keys_for_blocks(t):
        tb = t.reshape(bsz, nb, BLOCK, *t.shape[2:])
        prev = jnp.concatenate([jnp.zeros_like(tb[:, :1]), tb[:, :-1]], axis=1)
        meta = jnp.broadcast_to(t[:, None, BLOCK - N_META:BLOCK], (bsz, nb, N_META) + t.shape[2:])
        return jnp.concatenate([meta, prev, tb], axis=2)

    kk = keys_for_blocks(k)
    vv = keys_for_blocks(v)
    qpos = pos.reshape(nb, BLOCK)
    prev_pos = jnp.concatenate([jnp.full((1, BLOCK), -1, pos.dtype), qpos[:-1]], axis=0)
    meta_pos = jnp.broadcast_to(pos[BLOCK - N_META:BLOCK], (nb, N_META))
    kpos = jnp.concatenate([meta_pos, prev_pos, qpos], axis=1)
    dist = qpos[:, :, None] - kpos[:, None, :]
    is_meta_key = (jnp.arange(nk) < N_META)[None, None, :]
    band_ok = (kpos >= N_META)[:, None, :] & (dist >= 0) & (dist < WINDOW)
    allowed = jnp.where(is_meta_key, dist >= 0, band_ok)

    s = jnp.einsum('bnqkgd,bnskd->bnkgqs', qb, kk).astype(jnp.float32) * HEAD_DIM ** -0.5
    bias = table.astype(jnp.float32)[rel_bucket(dist)]
    bias = bias.reshape(nb, BLOCK, nk, A_KV_HEADS, grp).transpose(0, 3, 4, 1, 2)
    s = jnp.where(allowed[:, None, None], s + bias, NEG)
    sink = sinks.astype(jnp.float32).reshape(A_KV_HEADS, grp)[None, None, :, :, None, None]
    m = jnp.maximum(s.max(axis=-1, keepdims=True), sink)
    p = jnp.exp(s - m)
    w = p / (p.sum(axis=-1, keepdims=True) + jnp.exp(sink - m))
    o = jnp.einsum('bnkgqs,bnskd->bnqkgd', w.astype(v.dtype), vv)
    return o.reshape(bsz, P, A_HEADS * HEAD_DIM)


def differential_attention(q1, q2, k1, k2, v, pos, lam, lam_init, subln_g, table):
    bsz, P = q1.shape[:2]
    nb = P // BLOCK
    scale = B_QK_DIM ** -0.5
    table = table.astype(jnp.float32)
    key_ok = pos >= 0

    def to_blocks(t):
        return jnp.swapaxes(t.reshape(bsz, nb, BLOCK, *t.shape[2:]), 0, 1)

    def block_fn(args):
        qa, qb, qp = args
        dist = qp[:, None] - pos[None, :]
        allowed = (dist >= 0) & key_ok[None, :]
        bias = table[rel_bucket(dist)].transpose(2, 0, 1)

        def probs(qq, kk):
            s = jnp.einsum('bqhd,bshd->bhqs', qq, kk).astype(jnp.float32) * scale + bias
            return jax.nn.softmax(jnp.where(allowed, s, NEG), axis=-1)

        a = probs(qa, k1) - lam * probs(qb, k2)
        return jnp.einsum('bhqs,bshd->bqhd', a.astype(v.dtype), v)

    o = lax.map(block_fn, (to_blocks(q1), to_blocks(q2), pos.reshape(nb, BLOCK)))
    o = jnp.swapaxes(o, 0, 1).reshape(bsz, P, B_HEADS, B_V_DIM)
    o = rms_norm(o, subln_g) * (1.0 - lam_init)
    return o.reshape(bsz, P, B_HEADS * B_V_DIM)


def indexed_sparse_attention(q, k, v, qi, ki, wi, pos, topk, table):
    bsz, P = q.shape[:2]
    nb = P // BLOCK
    table = table.astype(jnp.float32)
    key_ok = pos >= 0
    gather = jax.vmap(lambda t, i: t[i])

    def to_blocks(t):
        return jnp.swapaxes(t.reshape(bsz, nb, BLOCK, *t.shape[2:]), 0, 1)

    def block_fn(args):
        qq, qiq, wq, qp = args
        dist = qp[:, None] - pos[None, :]
        admissible = (dist >= 0) & key_ok[None, :]
        rel = jax.nn.relu(jnp.einsum('bqhd,bsd->bqhs', qiq, ki).astype(jnp.float32) * IDX_DIM ** -0.5)
        score = jnp.einsum('bqhs,bqh->bqs', rel, wq.astype(jnp.float32)) * IDX_HEADS ** -0.5
        score = jnp.where(admissible[None], score, NEG)
        _, idx = lax.top_k(score, topk)
        k_sel = gather(k, idx)
        v_sel = gather(v, idx)
        kpos = pos[idx]
        dsel = qp[None, :, None] - kpos
        ok = (dsel >= 0) & (kpos >= 0)
        bias = jnp.swapaxes(table[rel_bucket(dsel)], 2, 3)
        s = jnp.einsum('bqhd,bqkd->bqhk', qq, k_sel).astype(jnp.float32) * HEAD_DIM ** -0.5 + bias
        p = jax.nn.softmax(jnp.where(ok[:, :, None, :], s, NEG), axis=-1)
        return jnp.einsum('bqhk,bqkd->bqhd', p.astype(v.dtype), v_sel)

    o = lax.map(block_fn, (to_blocks(q), to_blocks(qi), to_blocks(wi), pos.reshape(nb, BLOCK)))
    return jnp.swapaxes(o, 0, 1).reshape(bsz, P, C_HEADS * HEAD_DIM)


def hybrid_mixer(u, pos, topk, layer, w_in, sinks, diff_lambda, subln_g, w_branch, w_out, bias_table):
    bsz, P, _ = u.shape
    offsets = np.cumsum(IN_SPLITS)[:-1].tolist()
    (aq, ak, av, bq1, bq2, bk1, bk2, bv, cq, ck, cv, iq, ik, iw, gates) = jnp.split(u @ w_in, offsets, axis=-1)

    o_a = sliding_window_sink_attention(
        aq.reshape(bsz, P, A_HEADS, HEAD_DIM), ak.reshape(bsz, P, A_KV_HEADS, HEAD_DIM),
        av.reshape(bsz, P, A_KV_HEADS, HEAD_DIM), pos, sinks, bias_table[:, :A_HEADS])

    lam_init = 0.8 - 0.6 * math.exp(-0.3 * layer)
    lf = diff_lambda.astype(jnp.float32)
    lam = jnp.exp(jnp.sum(lf[0] * lf[1])) - jnp.exp(jnp.sum(lf[2] * lf[3])) + lam_init
    hb = lambda t, d: t.reshape(bsz, P, B_HEADS, d)
    o_b = differential_attention(
        hb(bq1, B_QK_DIM), hb(bq2, B_QK_DIM), hb(bk1, B_QK_DIM), hb(bk2, B_QK_DIM), hb(bv, B_V_DIM),
        pos, lam, lam_init, subln_g, bias_table[:, A_HEADS:A_HEADS + B_HEADS])

    o_c = indexed_sparse_attention(
        cq.reshape(bsz, P, C_HEADS, HEAD_DIM), ck, cv,
        iq.reshape(bsz, P, IDX_HEADS, IDX_DIM), ik, iw, pos, topk,
        bias_table[:, A_HEADS + B_HEADS:])

    g = jax.nn.sigmoid(gates.astype(jnp.float32)).astype(u.dtype).reshape(bsz, P, N_BRANCH, D_MODEL)
    y = (g[:, :, 0] * (o_a @ w_branch[0])
         + g[:, :, 1] * (o_b @ w_branch[1])
         + g[:, :, 2] * (o_c @ w_branch[2]))
    return y @ w_out


def setup_inputs(seed: int = 0) -> dict:
    key = jax.random.key(seed)
    ks = jax.random.split(key, 19)
    f32 = jnp.float32

    def nrm(k, shape, scale):
        return jax.random.normal(k, shape, f32) * scale

    def gain(k, shape):
        return 1.0 + 0.02 * jax.random.normal(k, shape, f32)

    return {
        "x": nrm(ks[0], (BATCH, SEQ, D_MODEL), 1.0),
        "meta_tokens": nrm(ks[1], (N_META, D_MODEL), 1.0),
        "rel_bias_table": nrm(ks[2], (N_BUCKETS, N_BIAS_HEADS), 0.5),
        "norm_ffn1": gain(ks[3], (DEPTH, D_MODEL)),
        "ffn1_w_gate": nrm(ks[4], (DEPTH, D_MODEL, D_FF), D_MODEL ** -0.5),
        "ffn1_w_up": nrm(ks[5], (DEPTH, D_MODEL, D_FF), D_MODEL ** -0.5),
        "ffn1_w_down": nrm(ks[6], (DEPTH, D_FF, D_MODEL), D_FF ** -0.5),
        "norm_mix": gain(ks[7], (DEPTH, D_MODEL)),
        "w_in": nrm(ks[8], (DEPTH, D_MODEL, D_IN), D_MODEL ** -0.5),
        "attn_sinks": nrm(ks[9], (DEPTH, A_HEADS), 0.5),
        "diff_lambda": nrm(ks[10], (DEPTH, 4, B_QK_DIM), 0.1),
        "diff_subln": gain(ks[11], (DEPTH, B_V_DIM)),
        "w_branch": nrm(ks[12], (DEPTH, N_BRANCH, BRANCH_WIDTH, D_MODEL), BRANCH_WIDTH ** -0.5),
        "w_out": nrm(ks[13], (DEPTH, D_MODEL, D_MODEL), D_MODEL ** -0.5),
        "norm_ffn2": gain(ks[14], (DEPTH, D_MODEL)),
        "ffn2_w_gate": nrm(ks[15], (DEPTH, D_MODEL, D_FF), D_MODEL ** -0.5),
        "ffn2_w_up": nrm(ks[16], (DEPTH, D_MODEL, D_FF), D_MODEL ** -0.5),
        "ffn2_w_down": nrm(ks[17], (DEPTH, D_FF, D_MODEL), D_FF ** -0.5),
        "norm_final": gain(ks[18], (D_MODEL,)),
    }


def reference(x, meta_tokens, rel_bias_table, norm_ffn1, ffn1_w_gate, ffn1_w_up, ffn1_w_down,
              norm_mix, w_in, attn_sinks, diff_lambda, diff_subln, w_branch, w_out,
              norm_ffn2, ffn2_w_gate, ffn2_w_up, ffn2_w_down, norm_final):
    bsz, seq_len, _ = x.shape
    n_pad = BLOCK - N_META
    h = jnp.concatenate([
        jnp.zeros((bsz, n_pad, D_MODEL), x.dtype),
        jnp.broadcast_to(meta_tokens.astype(x.dtype)[None], (bsz, N_META, D_MODEL)),
        x], axis=1)
    pos = jnp.arange(seq_len + BLOCK, dtype=jnp.int32) - n_pad
    topk = min(TOPK_MAX, seq_len // 4)

    for l in range(DEPTH):
        h = h + 0.5 * swiglu(rms_norm(h, norm_ffn1[l]), ffn1_w_gate[l], ffn1_w_up[l], ffn1_w_down[l])
        h = h + hybrid_mixer(rms_norm(h, norm_mix[l]), pos, topk, l, w_in[l], attn_sinks[l],
                             diff_lambda[l], diff_subln[l], w_branch[l], w_out[l], rel_bias_table)
        h = h + 0.5 * swiglu(rms_norm(h, norm_ffn2[l]), ffn2_w_gate[l], ffn2_w_up[l], ffn2_w_down[l])

    return rms_norm(h, norm_final)[:, BLOCK:]
```

```cpp
#include <hip/hip_runtime.h>
#include <cstdio>
#include <cstdint>
#ifndef MK_SPLIT
#define MK_SPLIT 0
#define MAXPH 20
#endif
__device__ __forceinline__ int lane_id() { return (int)__builtin_amdgcn_mbcnt_hi(~0u, __builtin_amdgcn_mbcnt_lo(~0u, 0u)); }
namespace pg8 {
#define PG8_LAS __attribute__((address_space(3)))
typedef unsigned short bf16_t;
typedef short bf16x8 __attribute__((ext_vector_type(8)));
typedef float f32x4 __attribute__((ext_vector_type(4)));
typedef unsigned u32x4 __attribute__((ext_vector_type(4)));
constexpr int BM = 256, BK = 64, HALF = 128, HTB = HALF * BK * 2  , STAGE_BYTES = 8 * HTB, NXCD = 8, WGM = 8;

__host__ __device__ __forceinline__ int lds_byte(int r, int c) { const int st = (r >> 4) * 2 + (c >> 5), rr = r & 15, cc = c & 31, ob = rr * 64 + cc * 2; return st * 1024 + (ob ^ (((ob >> 9) & 1) << 5)); }
__host__ __device__ __forceinline__ void stage_rc(int b, int& R, int& C) { const int st = b / 1024, sb = b % 1024, swz = sb ^ (((sb >> 9) & 1) << 5); R = (st >> 1) * 16 + swz / 64; C = (st & 1) * 32 + (swz % 64) / 2; }
__host__ __device__ __forceinline__ int perm32(int rho) { const int n = rho >> 4, i = rho & 15; return 8 * (i >> 2) + 4 * n + (i & 3); }

struct Unit { int pm, pn, seg; };
struct Gemm { const bf16_t* A; const bf16_t* Bt; int lda, ldb, Kloop; int bn_rows = 256; };

template <int NSEG> struct StaticOrder {
    int nM, nN, nwg, G, c;
    __device__ __forceinline__ void init(int M, int N, int G_, int c_) { nM = M / BM; nN = N / BM; nwg = nM * nN; G = G_; c = c_; }
    __device__ __forceinline__ bool next(int i, Unit& u) const {
        const int ti = i / NSEG; u.seg = i - ti * NSEG;
        const long L = (long)ti * G + c; if (L >= nwg) return false;
        int wgid = (int)L; { const int q = nwg / NXCD, r = nwg % NXCD, xcd = wgid % NXCD, off = wgid / NXCD; wgid = (xcd < r ? xcd * (q + 1) : r * (q + 1) + (xcd - r) * q) + off; }
        const int nig = WGM * nN, gid = wgid / nig, fm = gid * WGM, gsz = (nM - fm) < WGM ? (nM - fm) : WGM;
        u.pm = fm + ((wgid % nig) % gsz); u.pn = (wgid % nig) / gsz; return true;
    }
};

typedef int v8i32 __attribute__((ext_vector_type(8))); typedef int v4i32 __attribute__((ext_vector_type(4)));
__device__ __forceinline__ v8i32 cat8(bf16x8 a, bf16x8 b) { const v4i32 x = __builtin_bit_cast(v4i32, a), y = __builtin_bit_cast(v4i32, b); return __builtin_shufflevector(x, y, 0, 1, 2, 3, 4, 5, 6, 7); }
__device__ __forceinline__ unsigned cvt_pk_bf16(float lo, float hi) { unsigned r; asm volatile("v_cvt_pk_bf16_f32 %0, %1, %2" : "=v"(r) : "v"(lo), "v"(hi)); return r; }

template <class Epi, class Sched, bool ALIGN_EPI>
__device__ __forceinline__ void gemm_phase(PG8_LAS unsigned char* lds, const Gemm g, const Sched& S, const Epi& E, int wave_id) {
    int tid_ = wave_id * 64 + lane_id(); asm volatile("" : "+v"(tid_));
    const int tid = tid_, wid = __builtin_amdgcn_readfirstlane(tid >> 6), lane = tid & 63, wr = wid >> 2, wc = wid & 3, fr = lane & 15, fq = lane >> 4;
    const int nt = g.Kloop / BK;
    unsigned voffA[2], voffB[2];
#pragma unroll
    for (int i = 0; i < 2; ++i) { int R, C; stage_rc(tid * 16 + i * 8192, R, C); const int Rb = Epi::PERM ? ((R & ~31) + perm32(R & 31)) : R;
        voffA[i] = (unsigned)(R * g.lda + C) * 2u; voffB[i] = (unsigned)(Rb * g.ldb + C) * 2u; }
    const size_t kstep = (size_t)(BK * 2);
    const size_t hstepA = (size_t)HALF * g.lda * 2, hstepB = (size_t)HALF * g.ldb * 2;
    const size_t tstepA = 2 * hstepA, tstepB = (size_t)g.bn_rows * g.ldb * 2, sstep = (size_t)g.Kloop * 2;
    const unsigned ldsw = (unsigned)wid * 1024u;
    const int aoff = lds_byte(wr * 64 + fr, fq * 8), boff = lds_byte(wc * 32 + fr, fq * 8);
#define PG8_SA(b, h) (((b) * 2 + (h)) * HTB)
#define PG8_SB(b, h) ((4 + (b) * 2 + (h)) * HTB)
#define PG8_STAGE(bufoff, gbase, voff) do { _Pragma("unroll") for (int _i = 0; _i < 2; ++_i) \
        __builtin_amdgcn_global_load_lds((const unsigned*)((const char*)(gbase) + (voff)[_i]), (PG8_LAS unsigned*)(lds + (bufoff) + ldsw + _i * 8192), 16, 0, 0); } while (0)
#define PG8_LDA(dst, b, h) do { _Pragma("unroll") for (int m = 0; m < 4; ++m) { if constexpr (Epi::FP8) { dst##8[m].lo = *(const PG8_LAS v4i32*)(lds + PG8_SA(b, h) + aoff + m * 2048); dst##8[m].hi = *(const PG8_LAS v4i32*)(lds + PG8_SA(b, h) + aoff + m * 2048 + 1024); } \
        else { _Pragma("unroll") for (int k = 0; k < 2; ++k) dst[m][k] = *(const PG8_LAS bf16x8*)(lds + PG8_SA(b, h) + aoff + m * 2048 + k * 1024); } } } while (0)
#define PG8_LDB(dst, b, h) do { _Pragma("unroll") for (int n = 0; n < 2; ++n) { if constexpr (Epi::FP8) { dst##8[n].lo = *(const PG8_LAS v4i32*)(lds + PG8_SB(b, h) + boff + n * 2048); dst##8[n].hi = *(const PG8_LAS v4i32*)(lds + PG8_SB(b, h) + boff + n * 2048 + 1024); } \
        else { _Pragma("unroll") for (int k = 0; k < 2; ++k) dst[n][k] = *(const PG8_LAS bf16x8*)(lds + PG8_SB(b, h) + boff + n * 2048 + k * 1024); } } } while (0)
#define PG8_MMA(ai, bj, At, Bt) do { __builtin_amdgcn_s_setprio(1); _Pragma("unroll") for (int m = 0; m < 4; ++m) _Pragma("unroll") for (int n = 0; n < 2; ++n) { \
        if constexpr (Epi::FP8) asm volatile("v_mfma_f32_16x16x128_f8f6f4 %0, %1, %2, %0" : "+v"(acc[ai][bj][m][n]) : "v"(Bt##8[n]), "v"(At##8[m])); \
        else { _Pragma("unroll") for (int k = 0; k < 2; ++k) acc[ai][bj][m][n] = __builtin_amdgcn_mfma_f32_16x16x32_bf16(Bt[n][k], At[m][k], acc[ai][bj][m][n], 0, 0, 0); } } __builtin_amdgcn_s_setprio(0); } while (0)
#define PG8_WAIT_V(n) asm volatile("s_waitcnt vmcnt(" #n ")" ::: "memory")
#define PG8_WAIT_L(n) asm volatile("s_waitcnt lgkmcnt(" #n ")" ::: "memory")
#define PG8_BAR __builtin_amdgcn_s_barrier()
#define PG8_SCHED __builtin_amdgcn_sched_barrier(0)
    Unit cur, nxt; int ui = 0;
    if (!S.next(0, cur)) return;
    f32x4 acc[2][2][4][2];
#pragma unroll
    for (int a = 0; a < 2; ++a)
#pragma unroll
        for (int b = 0; b < 2; ++b)
#pragma unroll
            for (int m = 0; m < 4; ++m)
#pragma unroll
                for (int n = 0; n < 2; ++n) acc[a][b][m][n] = (f32x4){0.f, 0.f, 0.f, 0.f};
    bf16x8 At[4][2], B0[2][2], B1[2][2]; v8i32 At8[4], B08[2], B18[2];
    const char* cA = (const char*)g.A + (size_t)cur.pm * tstepA + (size_t)cur.seg * sstep; const char* cB = (const char*)g.Bt + (size_t)cur.pn * tstepB + (size_t)cur.seg * sstep;
    PG8_STAGE(PG8_SB(0, 0), cB, voffB); PG8_STAGE(PG8_SB(0, 1), cB + hstepB, voffB); PG8_STAGE(PG8_SA(0, 0), cA, voffA); PG8_STAGE(PG8_SA(0, 1), cA + hstepA, voffA);
    if (wr == 1) PG8_BAR;
    PG8_WAIT_V(2); PG8_BAR;
    PG8_STAGE(PG8_SB(1, 0), cB + kstep, voffB); PG8_STAGE(PG8_SA(1, 0), cA + kstep, voffA); PG8_STAGE(PG8_SB(1, 1), cB + hstepB + kstep, voffB);
    PG8_WAIT_V(6); PG8_BAR;
    for (;;) {
        const bool has_next = S.next(ui + 1, nxt);
        const char* nA = has_next ? (const char*)g.A + (size_t)nxt.pm * tstepA + (size_t)nxt.seg * sstep : cA; const char* nB = has_next ? (const char*)g.Bt + (size_t)nxt.pn * tstepB + (size_t)nxt.seg * sstep : cB;
        for (int t = 0; t < nt; t += 2) {
            const bool last = (t == nt - 2);
            const char* a1 = cA + (size_t)(t + 1) * kstep;
            const char* a2 = last ? nA : cA + (size_t)(t + 2) * kstep; const char* b2 = last ? nB : cB + (size_t)(t + 2) * kstep;
            const char* a3 = a2 + kstep; const char* b3 = b2 + kstep;
            PG8_LDB(B0, 0, 0); if constexpr (!Epi::NOB1) PG8_LDB(B1, 0, 1); PG8_SCHED; PG8_LDA(At, 0, 0); PG8_STAGE(PG8_SA(1, 1), a1 + hstepA, voffA);
            PG8_WAIT_V(8); PG8_WAIT_L(0); PG8_BAR; PG8_MMA(0, 0, At, B0); if constexpr (!Epi::NOB1) PG8_MMA(0, 1, At, B1); PG8_BAR; PG8_SCHED;
            PG8_LDA(At, 0, 1); PG8_STAGE(PG8_SB(0, 0), b2, voffB); PG8_STAGE(PG8_SB(0, 1), b2 + hstepB, voffB); PG8_STAGE(PG8_SA(0, 0), a2, voffA);
            PG8_WAIT_V(8); PG8_WAIT_L(0); PG8_BAR; PG8_MMA(1, 0, At, B0); if constexpr (!Epi::NOB1) PG8_MMA(1, 1, At, B1); PG8_BAR; PG8_SCHED;
            PG8_LDB(B0, 1, 0); if constexpr (!Epi::NOB1) PG8_LDB(B1, 1, 1); PG8_SCHED; PG8_LDA(At, 1, 0); PG8_STAGE(PG8_SA(0, 1), a2 + hstepA, voffA);
            PG8_WAIT_V(8); PG8_WAIT_L(0); PG8_BAR; PG8_MMA(0, 0, At, B0); if constexpr (!Epi::NOB1) PG8_MMA(0, 1, At, B1); PG8_BAR; PG8_SCHED;
            PG8_LDA(At, 1, 1); PG8_STAGE(PG8_SB(1, 0), b3, voffB); PG8_STAGE(PG8_SB(1, 1), b3 + hstepB, voffB); PG8_STAGE(PG8_SA(1, 0), a3, voffA);
            PG8_WAIT_V(8); PG8_WAIT_L(0); PG8_BAR; PG8_MMA(1, 0, At, B0); if constexpr (!Epi::NOB1) PG8_MMA(1, 1, At, B1); PG8_BAR; PG8_SCHED;
        }
        if constexpr (ALIGN_EPI) { if (wr == 0) PG8_BAR; }
        if constexpr (Epi::FP8) asm volatile("s_nop 15\n\ts_nop 15\n\ts_nop 7" ::: "memory");
        E(acc, cur, wr, wc, fr, fq);
        if (!has_next) break;
        if (nxt.seg == 0) {
#pragma unroll
        for (int a = 0; a < 2; ++a)
#pragma unroll
            for (int b = 0; b < 2; ++b)
#pragma unroll
                for (int m = 0; m < 4; ++m)
#pragma unroll
                    for (int n = 0; n < 2; ++n) acc[a][b][m][n] = (f32x4){0.f, 0.f, 0.f, 0.f};
        }
        cur = nxt; cA = nA; cB = nB; ++ui;
        if constexpr (ALIGN_EPI) { if (wr == 1) PG8_BAR; }
    }
    PG8_WAIT_V(0);
    if constexpr (!ALIGN_EPI) { if (wr == 0) PG8_BAR; }
    PG8_BAR;
#undef PG8_SA
#undef PG8_SB
#undef PG8_STAGE
#undef PG8_LDA
#undef PG8_LDB
#undef PG8_MMA
#undef PG8_WAIT_V
#undef PG8_WAIT_L
#undef PG8_BAR
#undef PG8_SCHED
}
}
constexpr int NWAVES = 8;
constexpr int D = 2048, FF = 5632, NBATCH = 8, T = 2048, MREAL = NBATCH * T, NMETA = 16, MP = 65 * 256  ;
constexpr int NGU = 2 * FF, NQKV = 2816, NGATE = 3 * D, NIN = NQKV + NGATE, NVT = 768, KBR = 1536, DIN = 9672;
constexpr float EPS = 1e-6f;
constexpr float LOG2E = 1.4426950408889634f;
constexpr int C_AQ = 0, C_AK = 512, C_BQ1 = 640, C_BQ2 = 896, C_BK1 = 1152, C_BK2 = 1408, C_CQ = 1664, C_CK = 2176, C_IQ = 2240, C_IK = 2752;
constexpr int R_AV = 0, R_BV = 128, R_CV = 640, R_IW = 704;
constexpr size_t MiB = 1u << 20;
constexpr size_t WS_CTL = 0, CTL_ZERO_BYTES = 2 * MiB;
constexpr size_t WS_WGU1 = 2 * MiB, WS_WD1 = WS_WGU1 + 44 * MiB, WS_WIN = WS_WD1 + 22 * MiB, WS_WVT = WS_WIN + 35 * MiB, WS_WBR = WS_WVT + 3 * MiB, WS_WOUT = WS_WBR + 6 * MiB,
                 WS_WGU2 = WS_WOUT + 8 * MiB, WS_WD2 = WS_WGU2 + 44 * MiB;
constexpr size_t WS_H = WS_WD2 + 22 * MiB;
constexpr size_t WS_HB = WS_H + 130 * MiB;
constexpr size_t WS_GG = WS_HB + 65 * MiB;
constexpr size_t WS_QKV = WS_GG + 195 * MiB;
constexpr size_t WS_VT = WS_QKV + 90 * MiB;
constexpr size_t WS_O = WS_VT + 25 * MiB;
constexpr size_t WS_HB8 = WS_O + 49 * MiB;
constexpr size_t WS_WG8 = WS_HB8 + 33 * MiB;
constexpr size_t WS_END = WS_WG8 + 13 * MiB;
constexpr size_t WS_WD81 = WS_H + 66 * MiB, WS_WD82 = WS_H + 78 * MiB;
#ifndef FP8_DN_FROM
#define FP8_DN_FROM 1
#endif
constexpr float G8_SCALE = 16.f;
constexpr float WG8_SCALE = 64.f;
static_assert(WS_WD1 - WS_WGU1 >= (size_t)NGU * D * 2 && WS_WIN - WS_WD1 >= (size_t)D * FF * 2 && WS_WVT - WS_WIN >= (size_t)NIN * D * 2 && WS_WBR - WS_WVT >= (size_t)NVT * D * 2 &&
              WS_WOUT - WS_WBR >= (size_t)D * KBR * 2 && WS_WGU2 - WS_WOUT >= (size_t)D * D * 2, "weight map");
static_assert(WS_HB - WS_H >= (size_t)MP * D * 4 && WS_GG - WS_HB >= (size_t)MP * D * 2 && WS_GG - WS_HB >= (size_t)256 * 32 * 2080 * 4 && WS_QKV - WS_GG >= (size_t)MP * NGATE * 2 &&
              WS_VT - WS_QKV >= (size_t)MP * NQKV * 2 && WS_O - WS_VT >= (size_t)NVT * MP * 2 && WS_HB8 - WS_O >= (size_t)MP * KBR * 2 && WS_WG8 - WS_HB8 >= (size_t)MP * D && WS_END - WS_WG8 >= (size_t)NGATE * D, "activation map");
constexpr int CW_TMO = 0, CW_CODE = 1, CW_BAR = 4096;
constexpr size_t CTL_SS = 65536;
static_assert(CTL_SS + 8 * (size_t)MP * 8 <= CTL_ZERO_BYTES, "ctl");
typedef unsigned long long ssq_t;
constexpr float SS_SCALE = 16777216.f;
constexpr int SROW = 2080;
constexpr int RING_BYTES = 131072;
constexpr int LDS_LUT = 131072, LUT_STRIDE = 132, LDS_MASK = LDS_LUT + 20 * LUT_STRIDE * 4  , MASK_STRIDE = 67, LDS_MISC = LDS_MASK + 32 * MASK_STRIDE * 4  ;
constexpr int LDS_BYTES = LDS_MISC + 256;
static_assert(LDS_BYTES <= 160 * 1024, "lds");

#define GAS __attribute__((address_space(1)))
#define LAS __attribute__((address_space(3)))
typedef unsigned short bf16;
typedef unsigned v4u __attribute__((ext_vector_type(4)));
typedef unsigned v2u __attribute__((ext_vector_type(2)));
typedef float f32x4 __attribute__((ext_vector_type(4)));
typedef float f32x16 __attribute__((ext_vector_type(16)));
typedef short bf16x8 __attribute__((ext_vector_type(8)));
typedef GAS unsigned gu32;
#define RLX_AGENT __ATOMIC_RELAXED, __HIP_MEMORY_SCOPE_AGENT
#define LDS_WAIT() asm volatile("s_waitcnt lgkmcnt(0)" ::: "memory")
#define VM_WAIT() asm volatile("s_waitcnt vmcnt(0)" ::: "memory")
__device__ __forceinline__ unsigned f2bf(float f) { unsigned u = __builtin_bit_cast(unsigned, f); return (u + 0x7fffu + ((u >> 16) & 1u)) >> 16; }
__device__ __forceinline__ unsigned pk2(float lo, float hi) { return f2bf(lo) | (f2bf(hi) << 16); }
__device__ __forceinline__ float clamp8(float v) { return __builtin_amdgcn_fmed3f(v, -448.f, 448.f); }
__device__ __forceinline__ unsigned pk_fp8x4(float a, float b, float c, float d) { unsigned w = 0u; a = clamp8(a); b = clamp8(b); c = clamp8(c); d = clamp8(d); w = (unsigned)__builtin_amdgcn_cvt_pk_fp8_f32(a, b, (int)w, false); w = (unsigned)__builtin_amdgcn_cvt_pk_fp8_f32(c, d, (int)w, true); return w; }
__device__ __forceinline__ float bf_lo(unsigned w) { return __builtin_bit_cast(float, w << 16); }
__device__ __forceinline__ float bf_hi(unsigned w) { return __builtin_bit_cast(float, w & 0xffff0000u); }
__device__ __forceinline__ float fast_exp2(float x) { return __builtin_amdgcn_exp2f(x); }
__device__ __forceinline__ float fast_rcp(float x) { return __builtin_amdgcn_rcpf(x); }
__device__ __forceinline__ float sigmoidf_(float x) { return fast_rcp(1.f + fast_exp2(-x * LOG2E)); }
__device__ __forceinline__ float rstd_of(ssq_t ss) { return rsqrtf((float)ss * (1.0f / (16777216.f * D)) + EPS); }
__device__ __forceinline__ ssq_t ss_fix(float v) { return (ssq_t)(v * SS_SCALE + 0.5f); }

using pg8::Unit; using pg8::cvt_pk_bf16;
typedef f32x4 AccT[2][2][4][2];
constexpr int LDS_RSC = 131072;
struct RsCache { LAS const float* rc; int slot;
    __device__ __forceinline__ RsCache(LAS const float* rc_, int pm) : rc(rc_) { const int t0 = ((LAS const int*)rc_)[512], t1 = ((LAS const int*)rc_)[513]; slot = (pm == t0) ? 0 : ((pm == t1) ? 256 : -1); }
    __device__ __forceinline__ float get(const ssq_t* ss, int row) const { return slot >= 0 ? rc[slot + (row & 255)] : rstd_of(ss[row]); } };
struct EpiSwiGLU {
    static constexpr bool PERM = true, FP8 = false, NOB1 = false;
    bf16* G; unsigned char* G8; const ssq_t* ss; LAS const float* rc;
    __device__ __forceinline__ void operator()(AccT& acc, const Unit& u, int wr, int wc, int fr, int fq) const {
        const int row0 = u.pm * 256 + wr * 64 + fr, col0 = u.pn * 128 + wc * 32 + 8 * fq; const RsCache R(rc, u.pm);
#pragma unroll
        for (int ai = 0; ai < 2; ++ai)
#pragma unroll
            for (int m = 0; m < 4; ++m) { const int row = row0 + ai * 128 + m * 16; const float rs = R.get(ss, row), k1 = -rs * LOG2E, k2 = rs * rs * (G8 ? G8_SCALE : 1.f);
                float o[8];
#pragma unroll
                for (int n = 0; n < 2; ++n) { const f32x4 ag = acc[ai][0][m][n], au = acc[ai][1][m][n];
                    f32x4 e = ag * k1;
#pragma unroll
                    for (int j = 0; j < 4; ++j) e[j] = fast_exp2(e[j]);
                    f32x4 d = e + 1.f;
#pragma unroll
                    for (int j = 0; j < 4; ++j) d[j] = fast_rcp(d[j]);
                    const f32x4 o4 = (ag * au) * (d * k2);
#pragma unroll
                    for (int j = 0; j < 4; ++j) o[4 * n + j] = o4[j]; }
                if (G8) { v2u w; w.x = pk_fp8x4(o[0], o[1], o[2], o[3]); w.y = pk_fp8x4(o[4], o[5], o[6], o[7]);
                    *(v2u*)(G8 + (size_t)row * FF + col0) = w; }
                else { v4u w; w.x = cvt_pk_bf16(o[0], o[1]); w.y = cvt_pk_bf16(o[2], o[3]); w.z = cvt_pk_bf16(o[4], o[5]); w.w = cvt_pk_bf16(o[6], o[7]);
                    *(v4u*)(G + (size_t)row * FF + col0) = w; } }
    }
};
template <bool W8, bool F8> struct EpiResidT {
    static constexpr bool PERM = true, FP8 = F8, NOB1 = false;
    bf16* HB; ssq_t* ssout; float alpha;
    __device__ __forceinline__ void operator()(AccT& acc, const Unit& u, int wr, int wc, int fr, int fq) const {
        const int row0 = u.pm * 256 + wr * 64 + fr, colb = u.pn * 256 + wc * 32 + 8 * fq;
        GAS unsigned char* hbg = (GAS unsigned char*)HB; const unsigned e00 = (unsigned)row0 * D + colb;
        v4u hv[2][4][2];
#pragma unroll
        for (int ai = 0; ai < 2; ++ai)
#pragma unroll
            for (int m = 0; m < 4; ++m)
#pragma unroll
                for (int bj = 0; bj < 2; ++bj) hv[ai][m][bj] = *(const GAS v4u*)(hbg + (e00 + (unsigned)((ai * 128 + m * 16) * D + bj * 128)) * 2u);
#pragma unroll
        for (int ai = 0; ai < 2; ++ai) {
#pragma unroll
            for (int m = 0; m < 4; ++m) { const int row = row0 + ai * 128 + m * 16; float part = 0.f;
#pragma unroll
                for (int bj = 0; bj < 2; ++bj) { const unsigned off = e00 + (unsigned)((ai * 128 + m * 16) * D + bj * 128); const v4u o = hv[ai][m][bj];
                    f32x4 h0, h1;
                    h0[0] = __builtin_bit_cast(float, o.x << 16); h0[1] = __builtin_bit_cast(float, o.x & 0xffff0000u); h0[2] = __builtin_bit_cast(float, o.y << 16); h0[3] = __builtin_bit_cast(float, o.y & 0xffff0000u);
                    h1[0] = __builtin_bit_cast(float, o.z << 16); h1[1] = __builtin_bit_cast(float, o.z & 0xffff0000u); h1[2] = __builtin_bit_cast(float, o.w << 16); h1[3] = __builtin_bit_cast(float, o.w & 0xffff0000u);
                    h0 = h0 + acc[ai][bj][m][0] * alpha; h1 = h1 + acc[ai][bj][m][1] * alpha;
                    v4u w; w.x = cvt_pk_bf16(h0[0], h0[1]); w.y = cvt_pk_bf16(h0[2], h0[3]); w.z = cvt_pk_bf16(h1[0], h1[1]); w.w = cvt_pk_bf16(h1[2], h1[3]);
                    *(GAS v4u*)(hbg + off * 2u) = w;
                    if constexpr (W8) { v2u w8v; w8v.x = pk_fp8x4(h0[0], h0[1], h0[2], h0[3]); w8v.y = pk_fp8x4(h1[0], h1[1], h1[2], h1[3]); *(GAS v2u*)(hbg + (WS_HB8 - WS_HB) + off) = w8v; }
                    part += (h0[0] * h0[0] + h0[1] * h0[1]) + (h0[2] * h0[2] + h0[3] * h0[3]) + (h1[0] * h1[0] + h1[1] * h1[1]) + (h1[2] * h1[2] + h1[3] * h1[3]); }
                part += __shfl_xor(part, 16); part += __shfl_xor(part, 32);
                if (fq == 0) atomicAdd(ssout + row, ss_fix(part)); }
            asm volatile("" ::: "memory"); }
    }
};
typedef EpiResidT<true, false> EpiResid; typedef EpiResidT<true, true> EpiResidF8; typedef EpiResidT<false, false> EpiResidNo8;
struct EpiIn {
    static constexpr bool PERM = true, FP8 = false, NOB1 = false;
    bf16* QKV; bf16* GATES; const ssq_t* ss; LAS const float* rc;
    __device__ __forceinline__ void operator()(AccT& acc, const Unit& u, int wr, int wc, int fr, int fq) const {
        const int row0 = u.pm * 256 + wr * 64 + fr; const bool isg = u.pn >= NQKV / 256; const RsCache R(rc, u.pm);
        bf16* base = isg ? GATES : QKV; const int ld = isg ? NGATE : NQKV; const int colb = (isg ? (u.pn - NQKV / 256) : u.pn) * 256 + wc * 32 + 8 * fq;
#pragma unroll
        for (int ai = 0; ai < 2; ++ai)
#pragma unroll
            for (int m = 0; m < 4; ++m) { const int row = row0 + ai * 128 + m * 16; const float rs = R.get(ss, row);
#pragma unroll
                for (int bj = 0; bj < 2; ++bj) { f32x4 v0 = acc[ai][bj][m][0] * rs, v1 = acc[ai][bj][m][1] * rs;
                    if (isg) {
#pragma unroll
                        for (int j = 0; j < 4; ++j) { v0[j] = sigmoidf_(v0[j]); v1[j] = sigmoidf_(v1[j]); } }
                    v4u w; w.x = cvt_pk_bf16(v0[0], v0[1]); w.y = cvt_pk_bf16(v0[2], v0[3]); w.z = cvt_pk_bf16(v1[0], v1[1]); w.w = cvt_pk_bf16(v1[2], v1[3]);
                    *(v4u*)(base + (size_t)row * ld + colb + bj * 128) = w; } }
    }
};
__device__ __forceinline__ float gate_code(float x) { return fmaxf(__builtin_rintf(sigmoidf_(x) * 255.f), 1.f); }
__device__ __forceinline__ float gate_code_k(float a, float k) { return fmaxf(__builtin_rintf(fast_rcp(__builtin_fmaf(fast_exp2(a * k), 1.f / 255.f, 1.f / 255.f))), 1.f); }
__device__ __forceinline__ unsigned pack_u8x4(float a, float b, float c, float d) {
    unsigned w = 0u; w = __builtin_amdgcn_cvt_pk_u8_f32(a, 0u, w); w = __builtin_amdgcn_cvt_pk_u8_f32(b, 1u, w); w = __builtin_amdgcn_cvt_pk_u8_f32(c, 2u, w); w = __builtin_amdgcn_cvt_pk_u8_f32(d, 3u, w); return w; }
struct EpiGates8 {
    static constexpr bool PERM = true, FP8 = true, NOB1 = false;
    unsigned char* GATES; const ssq_t* ss; LAS const float* rc;
    __device__ __forceinline__ void operator()(AccT& acc, const Unit& u, int wr, int wc, int fr, int fq) const {
        const int row0 = u.pm * 256 + wr * 64 + fr, colb = u.pn * 256 + wc * 32 + 8 * fq; const RsCache R(rc, u.pm);
        GAS unsigned char* gg = (GAS unsigned char*)GATES; const unsigned e00 = (unsigned)row0 * NGATE + colb;
#pragma unroll
        for (int ai = 0; ai < 2; ++ai)
#pragma unroll
            for (int m = 0; m < 4; ++m) { const int row = row0 + ai * 128 + m * 16; const float k = R.get(ss, row) * (-LOG2E / WG8_SCALE);
#pragma unroll
                for (int bj = 0; bj < 2; ++bj) { const f32x4 v0 = acc[ai][bj][m][0], v1 = acc[ai][bj][m][1];
                    v2u w; w.x = pack_u8x4(gate_code_k(v0[0], k), gate_code_k(v0[1], k), gate_code_k(v0[2], k), gate_code_k(v0[3], k)); w.y = pack_u8x4(gate_code_k(v1[0], k), gate_code_k(v1[1], k), gate_code_k(v1[2], k), gate_code_k(v1[3], k));
                    *(GAS v2u*)(gg + e00 + (unsigned)((ai * 128 + m * 16) * NGATE + bj * 128)) = w; } }
    }
};
struct EpiVT {
    static constexpr bool PERM = true, FP8 = false, NOB1 = false;
    bf16* VT; const ssq_t* ss;
    __device__ __forceinline__ void operator()(AccT& acc, const Unit& u, int wr, int wc, int fr, int fq) const {
        const int row0 = u.pm * 256 + wr * 64 + fr, colb = u.pn * 256 + wc * 32 + 8 * fq;
        float rs[2][8];
#pragma unroll
        for (int bj = 0; bj < 2; ++bj)
#pragma unroll
            for (int j = 0; j < 8; ++j) rs[bj][j] = rstd_of(ss[colb + bj * 128 + j]);
#pragma unroll
        for (int ai = 0; ai < 2; ++ai)
#pragma unroll
            for (int m = 0; m < 4; ++m) { const int row = row0 + ai * 128 + m * 16;
#pragma unroll
                for (int bj = 0; bj < 2; ++bj) { const f32x4 a0 = acc[ai][bj][m][0], a1 = acc[ai][bj][m][1];
                    v4u w; w.x = cvt_pk_bf16(a0[0] * rs[bj][0], a0[1] * rs[bj][1]); w.y = cvt_pk_bf16(a0[2] * rs[bj][2], a0[3] * rs[bj][3]);
                    w.z = cvt_pk_bf16(a1[0] * rs[bj][4], a1[1] * rs[bj][5]); w.w = cvt_pk_bf16(a1[2] * rs[bj][6], a1[3] * rs[bj][7]);
                    *(v4u*)(VT + (size_t)row * MP + colb + bj * 128) = w; } }
    }
};
struct EpiBr {
    static constexpr bool PERM = true, FP8 = false, NOB1 = false;
    bf16* Y; const unsigned char* GATES;
    __device__ __forceinline__ void operator()(AccT& acc, const Unit& u, int wr, int wc, int fr, int fq) const {
        const int row0 = u.pm * 256 + wr * 64 + fr, colb = u.pn * 256 + wc * 32 + 8 * fq; const int seg = u.seg;
        GAS const unsigned char* gg = (GAS const unsigned char*)GATES; const unsigned g00 = (unsigned)row0 * NGATE + colb + (unsigned)(seg * D);
        GAS unsigned char* yg = (GAS unsigned char*)Y; const unsigned y00 = ((unsigned)row0 * D + colb) * 2u;
        v2u gn[2][4][2], gd[2][4][2];
#pragma unroll
        for (int ai = 0; ai < 2; ++ai)
#pragma unroll
            for (int m = 0; m < 4; ++m)
#pragma unroll
                for (int bj = 0; bj < 2; ++bj) { const unsigned o = g00 + (unsigned)((ai * 128 + m * 16) * NGATE + bj * 128);
                    gn[ai][m][bj] = *(GAS const v2u*)(gg + o); gd[ai][m][bj] = (seg < 2) ? *(GAS const v2u*)(gg + o + D) : (v2u){0x01010101u, 0x01010101u}; }
        const float sc = (seg < 2) ? 1.f : (1.f / 255.f);
#pragma unroll
        for (int ai = 0; ai < 2; ++ai)
#pragma unroll
            for (int m = 0; m < 4; ++m)
#pragma unroll
                for (int bj = 0; bj < 2; ++bj) { const v2u n = gn[ai][m][bj], d = gd[ai][m][bj];
                    f32x4 v0 = acc[ai][bj][m][0], v1 = acc[ai][bj][m][1];
#pragma unroll
                    for (int j = 0; j < 4; ++j) { v0[j] *= (float)((n.x >> (8 * j)) & 0xffu) * sc * fast_rcp((float)((d.x >> (8 * j)) & 0xffu)); v1[j] *= (float)((n.y >> (8 * j)) & 0xffu) * sc * fast_rcp((float)((d.y >> (8 * j)) & 0xffu)); }
                    acc[ai][bj][m][0] = v0; acc[ai][bj][m][1] = v1;
                    if (seg == 2) { v4u w; w.x = cvt_pk_bf16(v0[0], v0[1]); w.y = cvt_pk_bf16(v0[2], v0[3]); w.z = cvt_pk_bf16(v1[0], v1[1]); w.w = cvt_pk_bf16(v1[2], v1[3]);
                        *(GAS v4u*)(yg + y00 + (unsigned)((ai * 128 + m * 16) * D + bj * 128) * 2u) = w; } }
    }
};

struct EpiNull {
    static constexpr bool PERM = true, FP8 = false, NOB1 = false;
    bf16* G;
    __device__ __forceinline__ void operator()(AccT& acc, const Unit& u, int wr, int wc, int fr, int fq) const {
        float s = 0.f;
#pragma unroll
        for (int ai = 0; ai < 2; ++ai)
#pragma unroll
            for (int bj = 0; bj < 2; ++bj)
#pragma unroll
                for (int m = 0; m < 4; ++m)
#pragma unroll
                    for (int n = 0; n < 2; ++n) s += acc[ai][bj][m][n][0] + acc[ai][bj][m][n][1] + acc[ai][bj][m][n][2] + acc[ai][bj][m][n][3];
        if (s == 12345.678f) G[0] = 1;
    }
};
#define XB_TMO      128
#define XB_XCNT(j)  (256  + 64 * (j))
#define XB_XSUB(j)  (1280 + 64 * (j))
#define XB_XGEN(j)  (2304 + 64 * (j))
#define XB_TOP      3328
#define XB_TOPGEN   3392
#define XCD_BAR_WORDS 3456
#define XB_SPIN_CAP (1u << 18)
__device__ __forceinline__ unsigned xb_ld(unsigned* p)              { return __hip_atomic_load(p, __ATOMIC_RELAXED, __HIP_MEMORY_SCOPE_AGENT); }
__device__ __forceinline__ unsigned xb_add(unsigned* p, unsigned v) { return __hip_atomic_fetch_add(p, v, __ATOMIC_RELAXED, __HIP_MEMORY_SCOPE_AGENT); }
__device__ __forceinline__ unsigned xb_xcc_id() { return (unsigned)__builtin_amdgcn_s_getreg((3 << 11) | 20) & 0xFu; }
#define XB_SPIN(cond, bar) do { unsigned _sp = 0; while (cond) { __builtin_amdgcn_s_sleep(1); \
    if ((++_sp & 255u) == 0u) { if (xb_ld(&(bar)[XB_TMO])) break; if (_sp > XB_SPIN_CAP) { atomicAdd(&(bar)[XB_TMO], 1u); break; } } } } while (0)
struct XcdBarrier { unsigned* bar; unsigned x; volatile LAS unsigned* st; int wv; };
__device__ __forceinline__ XcdBarrier xcd_barrier_post(unsigned* bar, volatile LAS unsigned* st, int wv) {
    XcdBarrier b; b.bar = bar; b.x = xb_xcc_id(); b.st = st; b.wv = wv;
    if (wv == 0 && lane_id() == 0) (void)xb_add(&bar[XB_XCNT(b.x)], 1u);
    return b;
}
__device__ __forceinline__ void xcd_barrier_complete(unsigned* bar, unsigned x, unsigned& nloc, unsigned& nx) {
    const unsigned G = gridDim.x * gridDim.y * gridDim.z;
    unsigned sum, cnt, mine, sp = 0u;
    for (;;) {
        sum = 0u; cnt = 0u; mine = 0u;
#pragma unroll
        for (unsigned j = 0; j < 16; ++j) { const unsigned c = xb_ld(&bar[XB_XCNT(j)]); sum += c; cnt += (c > 0u) ? 1u : 0u; mine = (j == x) ? c : mine; }
        if (sum == G) break;
        __builtin_amdgcn_s_sleep(1);
        if ((++sp & 255u) == 0u) { if (xb_ld(&bar[XB_TMO])) break; if (sp > XB_SPIN_CAP) { atomicAdd(&bar[XB_TMO], 1u); break; } }
    }
    nloc = mine > 0u ? mine : 1u; nx = cnt > 0u ? cnt : 1u;
}
__device__ __forceinline__ void xcd_barrier(const XcdBarrier& b) {
    asm volatile("s_waitcnt vmcnt(0)" ::: "memory");
    __syncthreads();
    if (b.wv == 0 && lane_id() == 0) {
        unsigned* bar = b.bar;
        __builtin_amdgcn_s_waitcnt(0);
        unsigned nloc = b.st[0], nx = b.st[1];
        if (nloc == 0u) { xcd_barrier_complete(bar, b.x, nloc, nx); b.st[0] = nloc; b.st[1] = nx; }
        const unsigned old = xb_add(&bar[XB_XSUB(b.x)], 1u);
        const unsigned gen = old / nloc;
        if (old + 1u == (gen + 1u) * nloc) {
            __builtin_amdgcn_fence(__ATOMIC_RELEASE, "agent");
            asm volatile("s_waitcnt vmcnt(0)" ::: "memory");
            const unsigned og = xb_add(&bar[XB_TOP], 1u);
            const unsigned tg = og / nx;
            if (og + 1u == (tg + 1u) * nx) xb_add(&bar[XB_TOPGEN], 1u);
            else XB_SPIN(xb_ld(&bar[XB_TOPGEN]) == tg, bar);
            __builtin_amdgcn_fence(__ATOMIC_ACQUIRE, "agent");
            xb_add(&bar[XB_XGEN(b.x)], 1u);
            asm volatile("s_waitcnt vmcnt(0)" ::: "memory");
        } else {
            XB_SPIN(xb_ld(&bar[XB_XGEN(b.x)]) == gen, bar);
            __builtin_amdgcn_fence(__ATOMIC_ACQUIRE, "agent");
            asm volatile("s_waitcnt vmcnt(0)" ::: "memory");
        }
    }
    __syncthreads();
}

struct Frame {
    LAS unsigned char* lds;
    int wave, G, wg;
    unsigned char* ws;
    const float* in[19];
    float* out;
};
__device__ __forceinline__ float wave_sum(float v) {
#pragma unroll
    for (int o = 1; o < 64; o <<= 1) v += __shfl_xor(v, o);
    return v;
}
enum { I_X = 0, I_META, I_TABLE, I_NF1, I_F1G, I_F1U, I_F1D, I_NMIX, I_WIN, I_SINK, I_DLAM, I_SUBLN, I_WBR, I_WOUT, I_NF2, I_F2G, I_F2U, I_F2D, I_NFIN };

typedef float f32x2c __attribute__((ext_vector_type(2)));
struct ConvItem { const float* sp; int pitch; const float* gain; bf16* WT; int K, drow0, k0; unsigned char* W8; int drow8; };
__device__ __forceinline__ void conv_load(const ConvItem& I, f32x2c (&v)[32]) {
#pragma unroll
    for (int i = 0; i < 32; ++i) v[i] = __builtin_nontemporal_load((const f32x2c*)(I.sp + (size_t)(2 * i) * I.pitch));
}
__device__ __forceinline__ void conv_to_lds(const f32x2c (&v)[32], LAS float* scr, int lane) {
#pragma unroll
    for (int i = 0; i < 32; ++i) { LAS float* d = scr + (2 * i + (lane >> 5)) * 65 + 2 * (lane & 31); d[0] = v[i].x; d[1] = v[i].y; }
}
__device__ __forceinline__ void conv_store(const ConvItem& I, LAS float* scr, int lane) {
    const int c = lane & 7;
    f32x4 g0 = (f32x4){1.f, 1.f, 1.f, 1.f}, g1 = g0;
    if (I.gain) { g0 = *(const f32x4*)(I.gain + I.k0 + 8 * c); g1 = *(const f32x4*)(I.gain + I.k0 + 8 * c + 4); }
    LDS_WAIT(); asm volatile("" ::: "memory");
#pragma unroll
    for (int j = 0; j < 8; ++j) { const int n = (lane >> 3) + 8 * j; const LAS float* s = scr + (8 * c) * 65 + n;
        const float e0 = s[0 * 65] * g0[0], e1 = s[1 * 65] * g0[1], e2 = s[2 * 65] * g0[2], e3 = s[3 * 65] * g0[3], e4 = s[4 * 65] * g1[0], e5 = s[5 * 65] * g1[1], e6 = s[6 * 65] * g1[2], e7 = s[7 * 65] * g1[3];
        v4u o; o.x = pk2(e0, e1); o.y = pk2(e2, e3); o.z = pk2(e4, e5); o.w = pk2(e6, e7);
        *(GAS v4u*)(I.WT + (size_t)(I.drow0 + n) * I.K + I.k0 + 8 * c) = o;
        if (I.W8) { v2u o8; o8.x = pk_fp8x4(e0 * WG8_SCALE, e1 * WG8_SCALE, e2 * WG8_SCALE, e3 * WG8_SCALE); o8.y = pk_fp8x4(e4 * WG8_SCALE, e5 * WG8_SCALE, e6 * WG8_SCALE, e7 * WG8_SCALE);
            *(GAS v2u*)(I.W8 + (size_t)(I.drow8 + n) * I.K + I.k0 + 8 * c) = o8; }
    }
    LDS_WAIT(); asm volatile("" ::: "memory");
}
__device__ __forceinline__ int win_src_col(int n) {
    if (n < 640) return n;
    if (n < 1664) return n - 640 + 768;
    if (n < 2240) return n - 1664 + 2304;
    if (n < 2816) return n - 2240 + 2944;
    return n - 2816 + 3528;
}
__device__ __forceinline__ int wvt_src_col(int n) {
    if (n < 128) return n + 640;
    if (n < 640) return n - 128 + 1792;
    if (n < 704) return n - 640 + 2880;
    return n - 704 + 3520;
}
namespace cv {
constexpr int I_GU = (D / 64) * (NGU / 64), I_DN = (FF / 64) * (D / 64), I_IN = (D / 64) * (NIN / 64), I_VT = (D / 64) * (NVT / 64), I_BR = (KBR / 64) * (D / 64), I_OUT = (D / 64) * (D / 64);
constexpr int E0 = I_GU, E1 = E0 + I_DN, E2 = E1 + I_GU, E3 = E2 + I_DN, E4 = E3 + I_IN, E5 = E4 + I_VT, E6 = E5 + I_BR, NITEMS = E6 + I_OUT;
constexpr int N_SET0 = E1 + (E5 - E3), N_SET1 = (E3 - E1) + (NITEMS - E5);
constexpr int JOB_ITEMS = 63;
constexpr int JOBS_SET0 = (N_SET0 + JOB_ITEMS - 1) / JOB_ITEMS, JOBS_SET1 = (N_SET1 + JOB_ITEMS - 1) / JOB_ITEMS;
}
__device__ __forceinline__ void convert_range(Frame& F, int l, int set, int v0, int vend, int vstride) {
    using namespace cv;
    int lane_ = lane_id(), wave_ = F.wave; asm volatile("" : "+v"(lane_)); asm volatile("" : "+s"(wave_));
    LAS float* scr = (LAS float*)(F.lds + wave_ * 16896);
    unsigned char* ws = F.ws;
    auto decode = [&](int v) -> ConvItem {
        const int it = (set == 0) ? (v < E1 ? v : v - E1 + E3) : (v < E3 - E1 ? v + E1 : v - (E3 - E1) + E5);
        const int m = (it >= E0) + (it >= E1) + (it >= E2) + (it >= E3) + (it >= E4) + (it >= E5) + (it >= E6);
        const int r = it - (m == 0 ? 0 : m == 1 ? E0 : m == 2 ? E1 : m == 3 ? E2 : m == 4 ? E3 : m == 5 ? E4 : m == 6 ? E5 : E6);
        const bool isgu = (m == 0 || m == 2), isdn = (m == 1 || m == 3);
        const int K = isdn ? FF : (m == 6 ? KBR : D);
        const int ndst = isgu ? NGU : (m == 4 ? NIN : (m == 5 ? NVT : D));
        const int nblk = ndst / 64, kb = r / nblk, nb = r - kb * nblk, n0 = nb * 64;
        const float* src; int pitch; const float* gain = nullptr; size_t dst;
        if (isgu) { const int tile = n0 >> 8, within = n0 & 255; const float* Wg = (m == 0) ? F.in[I_F1G] : F.in[I_F2G]; const float* Wu = (m == 0) ? F.in[I_F1U] : F.in[I_F2U];
            src = (within < 128 ? Wg : Wu) + (size_t)l * D * FF + tile * 128 + (within & 127); pitch = FF; gain = ((m == 0) ? F.in[I_NF1] : F.in[I_NF2]) + l * D; dst = (m == 0) ? WS_WGU1 : WS_WGU2; }
        else if (isdn) { src = ((m == 1) ? F.in[I_F1D] : F.in[I_F2D]) + (size_t)l * FF * D + n0; pitch = D; dst = (m == 1) ? WS_WD1 : WS_WD2; }
        else if (m == 4) { src = F.in[I_WIN] + (size_t)l * D * DIN + win_src_col(n0); pitch = DIN; gain = F.in[I_NMIX] + l * D; dst = WS_WIN; }
        else if (m == 5) { src = F.in[I_WIN] + (size_t)l * D * DIN + wvt_src_col(n0); pitch = DIN; gain = F.in[I_NMIX] + l * D; dst = WS_WVT; }
        else if (m == 6) { src = F.in[I_WBR] + (size_t)l * KBR * D + n0; pitch = D; dst = WS_WBR; }
        else { src = F.in[I_WOUT] + (size_t)l * D * D + n0; pitch = D; dst = WS_WOUT; }
        const bool g8 = ((m == 4) && (n0 >= NQKV)) || isdn;
        ConvItem I; I.sp = src + (size_t)(kb * 64 + (lane_ >> 5)) * pitch + 2 * (lane_ & 31); I.pitch = pitch; I.gain = gain; I.WT = (bf16*)(ws + dst); I.K = K; I.drow0 = n0; I.k0 = kb * 64;
        I.W8 = g8 ? ws + (isdn ? (m == 1 ? WS_WD81 : WS_WD82) : WS_WG8) : nullptr; I.drow8 = isdn ? n0 : n0 - NQKV; return I; };
    if (v0 < vend) {
        ConvItem cur = decode(v0); f32x2c v[32]; conv_load(cur, v);
        for (int it = v0; it < vend; it += vstride) {
            conv_to_lds(v, scr, lane_);
            const bool hn = it + vstride < vend; ConvItem nxt = cur;
            if (hn) { nxt = decode(it + vstride); conv_load(nxt, v); }
            conv_store(cur, scr, lane_);
            cur = nxt;
        }
    }
}
__device__ __forceinline__ void convert_layer(Frame& F, int l, int set) {
    convert_range(F, l, set, F.wg * NWAVES + F.wave, set == 0 ? cv::N_SET0 : cv::N_SET1, F.G * NWAVES);
}
__device__ __forceinline__ void convert_job(Frame& F, int l, int set, int j) {
    const int n = set == 0 ? cv::N_SET0 : cv::N_SET1, b = j * cv::JOB_ITEMS, e = b + cv::JOB_ITEMS < n ? b + cv::JOB_ITEMS : n;
    if (F.wave < 7) convert_range(F, l, set, b + F.wave, e, 7);
}
__device__ __forceinline__ void init_h(Frame& F) {
    int lane_ = lane_id(), wave_ = F.wave; asm volatile("" : "+v"(lane_)); asm volatile("" : "+s"(wave_));
    const int gw = F.wg * NWAVES + wave_, NGW = F.G * NWAVES;
    bf16* HB = (bf16*)(F.ws + WS_HB); ssq_t* ss0 = (ssq_t*)(F.ws + WS_CTL + CTL_SS);
    for (int row0 = gw; row0 < MP; row0 += 2 * NGW) {
        f32x4 v[2][8];
#pragma unroll
        for (int q = 0; q < 2; ++q) { const int row = row0 + q * NGW;
            const float* src = row < MREAL ? F.in[I_X] + (size_t)row * D : (row < MREAL + NMETA ? F.in[I_META] + (size_t)(row - MREAL) * D : nullptr);
#pragma unroll
            for (int j = 0; j < 8; ++j) v[q][j] = src ? __builtin_nontemporal_load((const f32x4*)(src + j * 256 + lane_ * 4)) : (f32x4){0.f, 0.f, 0.f, 0.f}; }
#pragma unroll
        for (int q = 0; q < 2; ++q) { const int row = row0 + q * NGW;
            if (row < MP) { float s = 0.f;
#pragma unroll
                for (int j = 0; j < 8; ++j) { const int c = j * 256 + lane_ * 4; const f32x4 x = v[q][j];
                    v2u w; w.x = pk2(x[0], x[1]); w.y = pk2(x[2], x[3]); *(v2u*)(HB + (size_t)row * D + c) = w;
                    s += (x[0] * x[0] + x[1] * x[1]) + (x[2] * x[2] + x[3] * x[3]); }
                s = wave_sum(s);
                if (lane_ == 0) ss0[row] = ss_fix(s); } }
    }
    bf16* O = (bf16*)(F.ws + WS_O);
    for (int i = gw * 64 + lane_; i < (MP - MREAL) * KBR / 8; i += NGW * 64) *(v4u*)(O + (size_t)MREAL * KBR + (size_t)i * 8) = (v4u){0u, 0u, 0u, 0u};
    bf16* QKVp = (bf16*)(F.ws + WS_QKV); bf16* VTp = (bf16*)(F.ws + WS_VT);
    for (int i = gw * 64 + lane_; i < 16 * NQKV / 8; i += NGW * 64) *(v4u*)(QKVp + (size_t)(MREAL + 16) * NQKV + (size_t)i * 8) = (v4u){0u, 0u, 0u, 0u};
    for (int i = gw * 64 + lane_; i < NVT * 2; i += NGW * 64) *(v4u*)(VTp + (size_t)(i >> 1) * MP + MREAL + 16 + 8 * (i & 1)) = (v4u){0u, 0u, 0u, 0u};
}
__device__ __forceinline__ void final_norm(Frame& F) {
    int lane_ = lane_id(), wave_ = F.wave; asm volatile("" : "+v"(lane_)); asm volatile("" : "+s"(wave_));
    const int gw = F.wg * NWAVES + wave_, NGW = F.G * NWAVES;
    const bf16* HB = (const bf16*)(F.ws + WS_HB); const ssq_t* ss = (const ssq_t*)(F.ws + WS_CTL + CTL_SS) + 6 * MP; const float* g = F.in[I_NFIN];
    f32x4 gv[8];
#pragma unroll
    for (int j = 0; j < 8; ++j) gv[j] = *(const f32x4*)(g + j * 256 + lane_ * 4);
    for (int row0 = gw; row0 < MREAL; row0 += 4 * NGW) {
        v2u o[4][8]; float rs[4];
#pragma unroll
        for (int q = 0; q < 4; ++q) { const int row = row0 + q * NGW; const int rr = row < MREAL ? row : row0;
            rs[q] = rstd_of(ss[rr]);
#pragma unroll
            for (int j = 0; j < 8; ++j) o[q][j] = __builtin_nontemporal_load((const v2u*)(HB + (size_t)rr * D + j * 256 + lane_ * 4)); }
#pragma unroll
        for (int q = 0; q < 4; ++q) { const int row = row0 + q * NGW;
            if (row < MREAL) {
#pragma unroll
                for (int j = 0; j < 8; ++j) { const v2u w = o[q][j];
                    f32x4 v; v[0] = __builtin_bit_cast(float, w.x << 16); v[1] = __builtin_bit_cast(float, w.x & 0xffff0000u); v[2] = __builtin_bit_cast(float, w.y << 16); v[3] = __builtin_bit_cast(float, w.y & 0xffff0000u);
                    __builtin_nontemporal_store(v * rs[q] * gv[j], (f32x4*)(F.out + (size_t)row * D + j * 256 + lane_ * 4)); } } }
    }
}
#define MFMA16(a, b, c) __builtin_amdgcn_mfma_f32_16x16x32_bf16((a), (b), (c), 0, 0, 0)
__device__ __forceinline__ f32x4 mini_dot(const bf16* A, int lda, const bf16* Bt, int ldb, int n0, int k0, int ksteps, int lane) {
    const int r = lane & 15, q = lane >> 4;
    const bf16* ap = A + (size_t)r * lda + k0 + 8 * q; const bf16* bp = Bt + (size_t)(n0 + r) * ldb + k0 + 8 * q;
    f32x4 acc = (f32x4){0.f, 0.f, 0.f, 0.f};
    int s = 0;
    for (; s + 8 <= ksteps; s += 8) {
        bf16x8 a[8], b[8];
#pragma unroll
        for (int i = 0; i < 8; ++i) { a[i] = *(const bf16x8*)(ap + 32 * (s + i)); b[i] = *(const bf16x8*)(bp + 32 * (s + i)); }
#pragma unroll
        for (int i = 0; i < 8; ++i) acc = MFMA16(a[i], b[i], acc);
    }
    for (; s + 2 <= ksteps; s += 2) { const bf16x8 a0 = *(const bf16x8*)(ap + 32 * s), b0 = *(const bf16x8*)(bp + 32 * s), a1 = *(const bf16x8*)(ap + 32 * s + 32), b1 = *(const bf16x8*)(bp + 32 * s + 32);
        acc = MFMA16(a0, b0, acc); acc = MFMA16(a1, b1, acc); }
    if (s < ksteps) { const bf16x8 a0 = *(const bf16x8*)(ap + 32 * s), b0 = *(const bf16x8*)(bp + 32 * s); acc = MFMA16(a0, b0, acc); }
    return acc;
}
template <int NACC, class Spec>
__device__ __forceinline__ void meta_gemm(Frame& F, const Spec& S, int ngroups) {
    int lane = lane_id(), wave = F.wave; asm volatile("" : "+v"(lane)); asm volatile("" : "+s"(wave));
    LAS float* part = (LAS float*)F.lds;
    constexpr int SLOTS = 4, SLOT_FLOATS = 8 * NACC * 256;
    for (int g0 = F.wg; g0 < ngroups; g0 += F.G * SLOTS) {
#pragma nounroll
        for (int sl = 0; sl < SLOTS; ++sl) { const int g = g0 + sl * F.G; if (g >= ngroups) break;
            f32x4 acc[NACC]; S.dot(g, wave, lane, acc);
#pragma unroll
            for (int a = 0; a < NACC; ++a)
#pragma unroll
                for (int j = 0; j < 4; ++j) part[sl * SLOT_FLOATS + ((wave * NACC + a) * 4 + j) * 64 + lane] = acc[a][j]; }
        __syncthreads();
        if (wave < SLOTS) { const int g = g0 + wave * F.G;
            if (g < ngroups) { f32x4 acc[NACC];
#pragma unroll
                for (int a = 0; a < NACC; ++a)
#pragma unroll
                    for (int j = 0; j < 4; ++j) { float s = 0.f;
#pragma unroll
                        for (int w = 0; w < 8; ++w) s += part[wave * SLOT_FLOATS + ((w * NACC + a) * 4 + j) * 64 + lane];
                        acc[a][j] = s; }
                S.epi(g, lane, acc); } }
        __syncthreads();
    }
}
template <int NACC, int KS, int SLOTS, class Spec>
__device__ __forceinline__ void meta_gemm2(Frame& F, const Spec& S, int ngroups, int vwg, int vG) {
    int lane = lane_id(), wave = F.wave; asm volatile("" : "+v"(lane)); asm volatile("" : "+s"(wave));
    LAS float* part = (LAS float*)F.lds;
    constexpr int SLOT_FLOATS = 8 * NACC * 256;
    const int r = lane & 15, q = lane >> 4, k0 = wave * KS * 32 + 8 * q;
    for (int g0 = (vwg < vG) ? vwg : ngroups; g0 < ngroups; g0 += vG * SLOTS) {
        bf16x8 a[KS], b[SLOTS][NACC][KS];
        { const bf16* ap = S.a_ptr() + (size_t)r * S.a_ld() + k0;
#pragma unroll
          for (int s = 0; s < KS; ++s) a[s] = *(const bf16x8*)(ap + 32 * s); }
#pragma unroll
        for (int sl = 0; sl < SLOTS; ++sl) { const int g = g0 + sl * vG;
            if (g < ngroups) {
#pragma unroll
                for (int c = 0; c < NACC; ++c) { const bf16* bp = S.w_ptr() + (size_t)(S.brow(g, c) + r) * S.w_ld() + k0;
#pragma unroll
                    for (int s = 0; s < KS; ++s) b[sl][c][s] = *(const bf16x8*)(bp + 32 * s); } } }
#pragma unroll
        for (int sl = 0; sl < SLOTS; ++sl) { const int g = g0 + sl * vG;
            if (g < ngroups) {
#pragma unroll
                for (int c = 0; c < NACC; ++c) { f32x4 acc = (f32x4){0.f, 0.f, 0.f, 0.f};
#pragma unroll
                    for (int s = 0; s < KS; ++s) acc = MFMA16(a[s], b[sl][c][s], acc);
#pragma unroll
                    for (int j = 0; j < 4; ++j) part[sl * SLOT_FLOATS + ((wave * NACC + c) * 4 + j) * 64 + lane] = acc[j]; } } }
        __syncthreads();
        if (wave < SLOTS) { const int g = g0 + wave * vG;
            if (g < ngroups) { f32x4 acc[NACC];
#pragma unroll
                for (int c = 0; c < NACC; ++c)
#pragma unroll
                    for (int j = 0; j < 4; ++j) { float sum = 0.f;
#pragma unroll
                        for (int w = 0; w < 8; ++w) sum += part[wave * SLOT_FLOATS + ((w * NACC + c) * 4 + j) * 64 + lane];
                        acc[c][j] = sum; }
                S.epi(g, lane, acc); } }
        __syncthreads();
    }
}
struct MetaGU { const bf16* A; const bf16* W; bf16* G; const ssq_t* ss;
    __device__ __forceinline__ const bf16* a_ptr() const { return A; } __device__ __forceinline__ int a_ld() const { return D; } __device__ __forceinline__ const bf16* w_ptr() const { return W; } __device__ __forceinline__ int w_ld() const { return D; }
    __device__ __forceinline__ int brow(int g, int c) const { const int c0 = 16 * g; return (c0 >> 7) * 256 + (c0 & 127) + 128 * c; }
    __device__ __forceinline__ void dot(int g, int wave, int lane, f32x4 (&acc)[2]) const { const int c0 = 16 * g, gr = (c0 >> 7) * 256 + (c0 & 127);
        acc[0] = mini_dot(A, D, W, D, gr, wave * (D / 8), D / 256, lane); acc[1] = mini_dot(A, D, W, D, gr + 128, wave * (D / 8), D / 256, lane); }
    __device__ __forceinline__ void epi(int g, int lane, const f32x4 (&acc)[2]) const { const int c = 16 * g + (lane & 15), q = lane >> 4;
#pragma unroll
        for (int j = 0; j < 4; ++j) { const int row = MREAL + 4 * q + j; const float rs = rstd_of(ss[row]); const float gv = acc[0][j] * rs, uv = acc[1][j] * rs;
            G[(size_t)row * FF + c] = (bf16)f2bf(gv * sigmoidf_(gv) * uv); } }
};
struct MetaResid { const bf16* A; int lda; const bf16* W; int K; bf16* HB; ssq_t* ssout; float alpha;
    __device__ __forceinline__ const bf16* a_ptr() const { return A; } __device__ __forceinline__ int a_ld() const { return lda; } __device__ __forceinline__ const bf16* w_ptr() const { return W; } __device__ __forceinline__ int w_ld() const { return K; }
    __device__ __forceinline__ int brow(int g, int) const { return 16 * g; }
    __device__ __forceinline__ void dot(int g, int wave, int lane, f32x4 (&acc)[1]) const { acc[0] = mini_dot(A, lda, W, K, 16 * g, wave * (K / 8), K / 256, lane); }
    __device__ __forceinline__ void epi(int g, int lane, const f32x4 (&acc)[1]) const { const int c = 16 * g + (lane & 15), q = lane >> 4;
#pragma unroll
        for (int j = 0; j < 4; ++j) { const int row = MREAL + 4 * q + j; const size_t off = (size_t)row * D + c; const float h = __builtin_bit_cast(float, (unsigned)HB[off] << 16) + alpha * acc[0][j];
            HB[off] = (bf16)f2bf(h); float p = h * h;
            p += __shfl_xor(p, 1); p += __shfl_xor(p, 2); p += __shfl_xor(p, 4); p += __shfl_xor(p, 8);
            if ((lane & 15) == 0) atomicAdd(ssout + row, ss_fix(p)); } }
};
struct MetaIn { const bf16* A; const bf16* W; bf16* QKV; unsigned char* GATES; const ssq_t* ss;
    __device__ __forceinline__ const bf16* a_ptr() const { return A; } __device__ __forceinline__ int a_ld() const { return D; } __device__ __forceinline__ const bf16* w_ptr() const { return W; } __device__ __forceinline__ int w_ld() const { return D; }
    __device__ __forceinline__ int brow(int g, int) const { return 16 * g; }
    __device__ __forceinline__ void dot(int g, int wave, int lane, f32x4 (&acc)[1]) const { acc[0] = mini_dot(A, D, W, D, 16 * g, wave * (D / 8), D / 256, lane); }
    __device__ __forceinline__ void epi(int g, int lane, const f32x4 (&acc)[1]) const { const int n = 16 * g + (lane & 15), q = lane >> 4;
#pragma unroll
        for (int j = 0; j < 4; ++j) { const int row = MREAL + 4 * q + j; const float v = acc[0][j] * rstd_of(ss[row]);
            if (n < NQKV) QKV[(size_t)row * NQKV + n] = (bf16)f2bf(v); else GATES[(size_t)row * NGATE + n - NQKV] = (unsigned char)gate_code(v); } }
};
struct MetaVT { const bf16* A; const bf16* W; bf16* VT; const ssq_t* ss;
    __device__ __forceinline__ const bf16* a_ptr() const { return A; } __device__ __forceinline__ int a_ld() const { return D; } __device__ __forceinline__ const bf16* w_ptr() const { return W; } __device__ __forceinline__ int w_ld() const { return D; }
    __device__ __forceinline__ int brow(int g, int) const { return 16 * g; }
    __device__ __forceinline__ void dot(int g, int wave, int lane, f32x4 (&acc)[1]) const { acc[0] = mini_dot(A, D, W, D, 16 * g, wave * (D / 8), D / 256, lane); }
    __device__ __forceinline__ void epi(int g, int lane, const f32x4 (&acc)[1]) const { const int n = 16 * g + (lane & 15), q = lane >> 4;
        v2u w; w.x = pk2(acc[0][0] * rstd_of(ss[MREAL + 4 * q]), acc[0][1] * rstd_of(ss[MREAL + 4 * q + 1])); w.y = pk2(acc[0][2] * rstd_of(ss[MREAL + 4 * q + 2]), acc[0][3] * rstd_of(ss[MREAL + 4 * q + 3]));
        *(v2u*)(VT + (size_t)n * MP + MREAL + 4 * q) = w; }
};
struct MetaBr { const bf16* O; const bf16* W; bf16* Y; const unsigned char* GATES;
    __device__ __forceinline__ void dot(int g, int wave, int lane, f32x4 (&acc)[3]) const {
#pragma unroll
        for (int b = 0; b < 3; ++b) acc[b] = mini_dot(O, KBR, W, KBR, 16 * g, 512 * b + wave * 64, 2, lane); }
    __device__ __forceinline__ void epi(int g, int lane, const f32x4 (&acc)[3]) const { const int c = 16 * g + (lane & 15), q = lane >> 4;
#pragma unroll
        for (int j = 0; j < 4; ++j) { const int row = MREAL + 4 * q + j; const unsigned char* gp = GATES + (size_t)row * NGATE + c;
            const float y = ((float)gp[0] * acc[0][j] + (float)gp[D] * acc[1][j] + (float)gp[2 * D] * acc[2][j]) * (1.f / 255.f);
            Y[(size_t)row * D + c] = (bf16)f2bf(y); } }
};
#define MFMA32(a, b, c) __builtin_amdgcn_mfma_f32_32x32x16_bf16((a), (b), (c), 0, 0, 0)
typedef float f32x2_t __attribute__((ext_vector_type(2))); typedef __bf16 bf16x2_t __attribute__((ext_vector_type(2)));
__device__ __forceinline__ unsigned cvtpk(float lo, float hi) { f32x2_t v = {lo, hi}; bf16x2_t b = __builtin_convertvector(v, bf16x2_t); return __builtin_bit_cast(unsigned, b); }
__device__ __forceinline__ int kappa(int r) { return (r & 0x13) | ((r & 4) << 1) | ((r & 8) >> 1); }
__device__ __forceinline__ int rel_bucket(int d) {
    if (d < 16) return d;
    return 16 + (d >= 19) + (d >= 21) + (d >= 24) + (d >= 27) + (d >= 31) + (d >= 35) + (d >= 40) + (d >= 46) + (d >= 52) + (d >= 59) + (d >= 67) + (d >= 77) + (d >= 87) + (d >= 99) + (d >= 113);
}
__device__ __forceinline__ void xhalf_swap(unsigned& a, unsigned& b) { asm volatile("v_nop\n\tv_nop\n\tv_permlane32_swap_b32 %0, %1" : "+v"(a), "+v"(b)); }
__device__ __forceinline__ float xhalf_max(float v) { unsigned a = __builtin_bit_cast(unsigned, v), b = a; xhalf_swap(a, b); return fmaxf(__builtin_bit_cast(float, a), __builtin_bit_cast(float, b)); }
__device__ __forceinline__ float xhalf_sum(float v) { unsigned a = __builtin_bit_cast(unsigned, v), b = a; xhalf_swap(a, b); return __builtin_bit_cast(float, a) + __builtin_bit_cast(float, b); }
constexpr float NEG_INF = -__builtin_huge_valf();
constexpr float M_INIT = -1e30f;

constexpr int AT_ROW = 144, AT_K_BYTES = 64 * AT_ROW, AT_V_BYTES = 128 * AT_ROW, AT_BUF = AT_K_BYTES + AT_V_BYTES;
constexpr int AT_TPB = 2;
static_assert(2 * AT_TPB * AT_BUF <= RING_BYTES, "attention tile buffers");
__device__ __forceinline__ int slot_row(int b, int s) { return s < 32 ? MREAL + s : b * T + s - 32; }
__device__ __forceinline__ float mask_sel(float v, unsigned w, int off) { const unsigned m = (unsigned)__builtin_amdgcn_sbfe((int)w, off, 1); float r;
    asm("v_bfi_b32 %0, %1, %2, %3" : "=v"(r) : "v"(m), "v"(v), "s"(0xff800000u)); return r; }
template <int DV> struct TileRegs { v4u k; v4u v[DV / 64]; };
template <int DV> __device__ __forceinline__ void tile_load(TileRegs<DV>& R, const bf16* __restrict__ QKV, const bf16* __restrict__ VT, int b, int kcol, int vrow, int st, int tid) {
    { const int row = tid >> 3, ch = tid & 7; R.k = *(const v4u*)(QKV + (size_t)slot_row(b, 64 * st + row) * NQKV + kcol + 8 * ch); }
#pragma unroll
    for (int i = 0; i < DV / 64; ++i) { const int p = tid + 512 * i, d = p >> 3, ch = p & 7; R.v[i] = *(const v4u*)(VT + (size_t)(vrow + d) * MP + slot_row(b, 64 * st + 8 * ch)); }
}
template <int DV> __device__ __forceinline__ void tile_store(const TileRegs<DV>& R, LAS unsigned char* buf, int tid) {
    { const int row = tid >> 3, ch = tid & 7; *(LAS v4u*)(buf + row * AT_ROW + 16 * ch) = R.k; }
#pragma unroll
    for (int i = 0; i < DV / 64; ++i) { const int p = tid + 512 * i, d = p >> 3, ch = p & 7; *(LAS v4u*)(buf + AT_K_BYTES + d * AT_ROW + 16 * ch) = R.v[i]; }
}
template <int ND, int MODE, int TPB>
__device__ __forceinline__ float flash_job(f32x16 (&O)[ND], const bf16* __restrict__ QKV, const bf16* __restrict__ VT, LAS unsigned char* lds, int b, int kcol, int vrow, int st_lo, int st_hi,
                                           bool active, int j, int qcol, const LAS float* lut, float m0, float l0, const LAS unsigned* mrow, int tid, int lane) {
    constexpr int DV = 32 * ND;
    const int r = lane & 31, h = lane >> 5, kap = kappa(r);
    const int qrow = (j >= 0) ? b * T + 32 * j + r : MREAL + r;
    const int qs = (j >= 0) ? 32 * (j + 1) + r : r;
    const int qp = qs < 32 ? qs : qs - 16;
    const int qs_hi = (j >= 0) ? 32 * (j + 1) + 31 : 31;
    bf16x8 qf[4];
#pragma unroll
    for (int d0 = 0; d0 < 4; ++d0) qf[d0] = *(const bf16x8*)(QKV + (size_t)qrow * NQKV + qcol + 16 * d0 + 8 * h);
    float m = m0, l = l0;
#pragma unroll
    for (int d = 0; d < ND; ++d)
#pragma unroll
        for (int i = 0; i < 16; ++i) O[d][i] = 0.f;
    const float c = 0.125f * LOG2E;
    const float lut_far = lut[128];
    constexpr int ABUF = (MODE == 0) ? AT_K_BYTES + DV * AT_ROW : AT_BUF;
    static_assert(MODE != 0 || TPB * ABUF <= RING_BYTES, "window-attention tiles");
    const int s1 = st_lo > 1 ? st_lo : 1;
#define FJ_TILE(sg_, tt_) ((MODE == 0) ? ((tt_) == 0 ? 0 : s1 + (tt_) - 1) : (sg_) + (tt_))
    TileRegs<DV> R[TPB];
    __syncthreads();
#pragma unroll
    for (int tt = 0; tt < TPB; ++tt) if (MODE != 0 || FJ_TILE(0, tt) <= st_hi) tile_load<DV>(R[tt], QKV, VT, b, kcol, vrow, FJ_TILE(0, tt), tid);
    int sg = 0, pb = 0;
    for (;;) {
        LAS unsigned char* gbuf = lds + pb * (TPB * ABUF);
#pragma unroll
        for (int tt = 0; tt < TPB; ++tt) if (MODE != 0 || FJ_TILE(sg, tt) <= st_hi) tile_store<DV>(R[tt], gbuf + tt * ABUF, tid);
        __syncthreads();
        const int nsg = (MODE == 0) ? st_hi + 1 : sg + TPB;
        if (nsg <= st_hi) {
#pragma unroll
            for (int tt = 0; tt < TPB; ++tt) tile_load<DV>(R[tt], QKV, VT, b, kcol, vrow, nsg + tt, tid); }
#pragma unroll
        for (int tt = 0; tt < TPB; ++tt) {
        const int st = FJ_TILE(sg, tt); LAS unsigned char* buf = gbuf + tt * ABUF;
        bool need = active && (64 * st <= qs_hi);
        if (MODE == 0 && st > 0) need = need && (64 * st + 63 >= 32 * (j + 1) - 127);
        if (need) {
            constexpr int NH = 2;
#pragma unroll
            for (int h0 = 0; h0 < 2; h0 += NH) {
                f32x16 sv[NH];
#pragma unroll
                for (int e = 0; e < NH; ++e)
#pragma unroll
                    for (int i = 0; i < 16; ++i) sv[e][i] = 0.f;
#pragma unroll
                for (int d0 = 0; d0 < 4; ++d0)
#pragma unroll
                    for (int e = 0; e < NH; ++e) { const bf16x8 kk = *(const LAS bf16x8*)(buf + (32 * (h0 + e) + kap) * AT_ROW + 32 * d0 + 16 * h); sv[e] = MFMA32(kk, qf[d0], sv[e]); }
                unsigned wm[NH];
#pragma unroll
                for (int e = 0; e < NH; ++e) wm[e] = (MODE == 2) ? mrow[2 * st + h0 + e] : 0u;
                const bool far = (MODE != 0) && (st >= 1) && (32 * j - 64 * st >= 159);
                float t[16 * NH];
                if (far) {
#pragma unroll
                    for (int e = 0; e < NH; ++e)
#pragma unroll
                        for (int i = 0; i < 16; ++i) { const int off = 16 * (i >> 3) + 8 * h + (i & 7); const float v = sv[e][i] * c + lut_far;
                            t[16 * e + i] = (MODE == 2) ? mask_sel(v, wm[e], off) : v; }
                } else {
                    float bl[16 * NH];
#pragma unroll
                    for (int e = 0; e < NH; ++e)
#pragma unroll
                        for (int i = 0; i < 16; ++i) { const int off = 16 * (i >> 3) + 8 * h + (i & 7); const int ks = 64 * st + 32 * (h0 + e) + off; const int kp = ks < 32 ? ks : ks - 16; const int dist = qp - kp;
                            const int idx = dist < 0 ? 0 : (dist > 128 ? 128 : dist); bl[16 * e + i] = lut[idx]; }
                    __builtin_amdgcn_sched_barrier(0);
#pragma unroll
                    for (int e = 0; e < NH; ++e)
#pragma unroll
                        for (int i = 0; i < 16; ++i) { const int off = 16 * (i >> 3) + 8 * h + (i & 7); const int ks = 64 * st + 32 * (h0 + e) + off; const int kp = ks < 32 ? ks : ks - 16; const int dist = qp - kp;
                            const float v = sv[e][i] * c + bl[16 * e + i];
                            if (MODE == 2) t[16 * e + i] = mask_sel(v, wm[e], off);
                            else { bool ok = (dist >= 0) && (ks < 16 || ks >= 32); if (MODE == 0) ok = ok && (ks < 32 || dist < 128); t[16 * e + i] = ok ? v : NEG_INF; } }
                }
                float tmax = t[0];
#pragma unroll
                for (int i = 1; i < 16 * NH; ++i) tmax = fmaxf(tmax, t[i]);

                if (__any(tmax > m + 8.f)) { const float mnew = fmaxf(m, xhalf_max(tmax)); const float alpha = fast_exp2(m - mnew); l *= alpha;
#pragma unroll
                    for (int d = 0; d < ND; ++d)
#pragma unroll
                        for (int i = 0; i < 16; ++i) O[d][i] *= alpha;
                    m = mnew; }
                float ps = 0.f;
#pragma unroll
                for (int i = 0; i < 16 * NH; ++i) { t[i] = fast_exp2(t[i] - m); ps += t[i]; }
                l += ps;
                bf16x8 pf[2 * NH];
#pragma unroll
                for (int g = 0; g < 2 * NH; ++g) { v4u pw; pw.x = cvtpk(t[8 * g], t[8 * g + 1]); pw.y = cvtpk(t[8 * g + 2], t[8 * g + 3]); pw.z = cvtpk(t[8 * g + 4], t[8 * g + 5]); pw.w = cvtpk(t[8 * g + 6], t[8 * g + 7]); pf[g] = __builtin_bit_cast(bf16x8, pw); }
#pragma unroll
                for (int d = 0; d < ND; ++d)
#pragma unroll
                    for (int g = 0; g < 2 * NH; ++g) { const bf16x8 vf = *(const LAS bf16x8*)(buf + AT_K_BYTES + (32 * d + r) * AT_ROW + 64 * h0 + 32 * g + 16 * h); O[d] = MFMA32(vf, pf[g], O[d]); }
            }
        }
        }
        if (nsg > st_hi) break;
        sg = nsg; pb ^= 1;
    }
#undef FJ_TILE
    return xhalf_sum(l);
}
template <int ND>
__device__ __forceinline__ void store_o(bf16* Obuf, int qrow, int col0, const f32x16 (&O)[ND], float scale, bool valid, int lane) {
    const int h = lane >> 5;
    if (!valid) return;
#pragma unroll
    for (int d = 0; d < ND; ++d)
#pragma unroll
        for (int g = 0; g < 4; ++g) { v2u w; w.x = cvtpk(O[d][4 * g] * scale, O[d][4 * g + 1] * scale); w.y = cvtpk(O[d][4 * g + 2] * scale, O[d][4 * g + 3] * scale);
            *(v2u*)(Obuf + (size_t)qrow * KBR + col0 + 32 * d + 8 * g + 4 * h) = w; }
}
struct AttnCtx { const bf16* QKV; const bf16* VT; bf16* O; const LAS float* lut; const float* sinks; const float* subln; float lam, lam_init; LAS unsigned char* lds; };

__device__ __forceinline__ void job_a(const AttnCtx& C, int b, int kvh, int jp, int tid, int wave, int lane) {
    asm volatile("" : "+v"(lane)); asm volatile("" : "+v"(tid));
    f32x16 O[2]; const int r = lane & 31, h = lane >> 5, hq = kvh * 4 + (wave & 3);
    const int j = jp >= 0 ? 2 * jp + (wave >> 2) : -1; const bool active = jp >= 0 || wave < 4;
    const int st_lo = jp >= 0 ? jp - 2 : 1, st_hi = jp >= 0 ? jp + 1 : 0;
    const float l = flash_job<2, 0, 5>(O, C.QKV, C.VT, C.lds, b, C_AK + kvh * 64, R_AV + kvh * 64, st_lo, st_hi, active, j, C_AQ + hq * 64, C.lut + hq * LUT_STRIDE, C.sinks[hq] * LOG2E, h == 0 ? 1.f : 0.f, nullptr, tid, lane);
    const int qrow = (j >= 0) ? b * T + 32 * j + r : MREAL + r;
    store_o<2>(C.O, qrow, hq * 64, O, 1.f / l, active && (j >= 0 || r < NMETA), lane);
}
__device__ __forceinline__ void job_c(const AttnCtx& C, int b, int j, const LAS unsigned* mask, int tid, int wave, int lane) {
    asm volatile("" : "+v"(lane)); asm volatile("" : "+v"(tid));
    f32x16 O[2]; const int r = lane & 31; const int st_hi = j >= 0 ? (j + 1) >> 1 : 0;
    float l;
    if (j >= 0) l = flash_job<2, 2, AT_TPB>(O, C.QKV, C.VT, C.lds, b, C_CK, R_CV, 1, st_hi, true, j, C_CQ + wave * 64, C.lut + (12 + wave) * LUT_STRIDE, M_INIT, 0.f, mask + r * MASK_STRIDE, tid, lane);
    else        l = flash_job<2, 1, AT_TPB>(O, C.QKV, C.VT, C.lds, b, C_CK, R_CV, 1, st_hi, true, j, C_CQ + wave * 64, C.lut + (12 + wave) * LUT_STRIDE, M_INIT, 0.f, nullptr, tid, lane);
    const int qrow = (j >= 0) ? b * T + 32 * j + r : MREAL + r;
    store_o<2>(C.O, qrow, 1024 + wave * 64, O, 1.f / l, j >= 0 || r < NMETA, lane);
}
__device__ __forceinline__ void job_b(const AttnCtx& C, int b, int hd, int g, float* stash  , int tid, int wave, int lane) {
    const LAS float* lut = C.lut + (8 + hd) * LUT_STRIDE;
    const int j = g >= 0 ? 8 * g + wave : -1; const bool active = g >= 0 || wave == 0; const int st_hi = g >= 0 ? 4 * g + 4 : 0;
#pragma nounroll
    for (int map = 0; map < 2; ++map) {
        asm volatile("" : "+v"(lane)); asm volatile("" : "+v"(tid));
        f32x16 O[4]; const int r = lane & 31, h = lane >> 5;
        const float l = flash_job<4, 1, AT_TPB>(O, C.QKV, C.VT, C.lds, b, (map ? C_BK2 : C_BK1) + hd * 64, R_BV + hd * 128, 1, st_hi, active, j, (map ? C_BQ2 : C_BQ1) + hd * 64, lut, M_INIT, 0.f, nullptr, tid, lane);
        if (!active) continue;
        if (map == 0) { const float inv = 1.f / l;
#pragma unroll
            for (int d = 0; d < 4; ++d)
#pragma unroll
                for (int g4 = 0; g4 < 4; ++g4) *(f32x4*)(stash + lane * 64 + d * 16 + g4 * 4) = (f32x4){O[d][4 * g4] * inv, O[d][4 * g4 + 1] * inv, O[d][4 * g4 + 2] * inv, O[d][4 * g4 + 3] * inv};
        } else {
            const float inv = C.lam / l; float ssq = 0.f;
#pragma unroll
            for (int d = 0; d < 4; ++d)
#pragma unroll
                for (int g4 = 0; g4 < 4; ++g4) { const f32x4 sv4 = *(const f32x4*)(stash + lane * 64 + d * 16 + g4 * 4);
#pragma unroll
                    for (int k = 0; k < 4; ++k) { const float o = sv4[k] - O[d][4 * g4 + k] * inv; O[d][4 * g4 + k] = o; ssq += o * o; } }
            ssq = xhalf_sum(ssq);
            const float rs = rsqrtf(ssq * (1.0f / 128.f) + EPS) * (1.f - C.lam_init);
#pragma unroll
            for (int d = 0; d < 4; ++d)
#pragma unroll
                for (int gg = 0; gg < 4; ++gg) { const f32x4 gv = *(const f32x4*)(C.subln + 32 * d + 8 * gg + 4 * h);
#pragma unroll
                    for (int k = 0; k < 4; ++k) O[d][4 * gg + k] *= gv[k]; }
            const int qrow = (j >= 0) ? b * T + 32 * j + r : MREAL + r;
            store_o<4>(C.O, qrow, 512 + hd * 128, O, rs, j >= 0 || r < NMETA, lane);
        }
    }
}
constexpr int AT_QI_OFF = 0, AT_QI_ROW = 1040;
static_assert(AT_QI_OFF + 32 * AT_QI_ROW <= RING_BYTES, "indexer Q stage");
__device__ __forceinline__ void idx_scores(const AttnCtx& C, int b, int j, float* Sws, int tid, int wave, int lane) {
    asm volatile("" : "+v"(lane)); asm volatile("" : "+v"(tid));
    const int r = lane & 31, h = lane >> 5, kap = kappa(r);
    const int qrow0 = b * T + 32 * j;
    LAS unsigned char* qs = C.lds + AT_QI_OFF;
    __syncthreads();
#pragma unroll
    for (int i = 0; i < 4; ++i) { const int p = tid + 512 * i, row = p >> 6, ch = p & 63;
        *(LAS v4u*)(qs + row * AT_QI_ROW + 16 * ch) = *(const v4u*)(C.QKV + (size_t)(qrow0 + row) * NQKV + C_IQ + 8 * ch); }
    float wq[8];
#pragma unroll
    for (int hd = 0; hd < 8; ++hd) wq[hd] = __builtin_bit_cast(float, (unsigned)C.VT[(size_t)(R_IW + hd) * MP + qrow0 + r] << 16) * (0.125f * 0.35355339059327373f);
    float* Srow = Sws + (size_t)r * SROW;
    bf16x8 kn[4];
    if (wave <= j + 1) { const int krow0 = (wave == 0) ? MREAL : b * T + 32 * (wave - 1);
#pragma unroll
        for (int d0 = 0; d0 < 4; ++d0) kn[d0] = *(const bf16x8*)(C.QKV + (size_t)(krow0 + kap) * NQKV + C_IK + 16 * d0 + 8 * h); }
    __syncthreads();
    float sp[16]; int ktp = -1;
#define IDX_STORE_PREV() do { if (ktp >= 0) { _Pragma("unroll") for (int q4 = 0; q4 < 4; ++q4) \
        *(f32x4*)(Srow + 32 * ktp + 16 * (q4 >> 1) + 8 * h + 4 * (q4 & 1)) = (f32x4){sp[4 * q4], sp[4 * q4 + 1], sp[4 * q4 + 2], sp[4 * q4 + 3]}; } } while (0)
    for (int kt = wave; kt <= j + 1; kt += 8) {
        bf16x8 kf[4];
#pragma unroll
        for (int d0 = 0; d0 < 4; ++d0) kf[d0] = kn[d0];
        IDX_STORE_PREV();
        if (kt + 8 <= j + 1) { const int krow1 = b * T + 32 * (kt + 7);
#pragma unroll
            for (int d0 = 0; d0 < 4; ++d0) kn[d0] = *(const bf16x8*)(C.QKV + (size_t)(krow1 + kap) * NQKV + C_IK + 16 * d0 + 8 * h); }
        float sc[16];
#pragma unroll
        for (int i = 0; i < 16; ++i) sc[i] = 0.f;
#pragma unroll
        for (int hd = 0; hd < 8; ++hd) { f32x16 a;
#pragma unroll
            for (int i = 0; i < 16; ++i) a[i] = 0.f;
#pragma unroll
            for (int d0 = 0; d0 < 4; ++d0) { const bf16x8 qf = *(const LAS bf16x8*)(qs + r * AT_QI_ROW + hd * 128 + 32 * d0 + 16 * h); a = MFMA32(kf[d0], qf, a); }
#pragma unroll
            for (int i = 0; i < 16; ++i) sc[i] += fmaxf(a[i], 0.f) * wq[hd];
            if (hd & 1) __builtin_amdgcn_sched_barrier(0); }
#pragma unroll
        for (int i = 0; i < 16; ++i) { const int koff = (i & 7) + 8 * h + 16 * (i >> 3);
            const bool ok = (kt == 0) ? (koff < 16) : (kt == j + 1 ? koff <= r : true);
            float v = sc[i]; if ((__builtin_bit_cast(unsigned, v) & 0x7fffffffu) == 0u) v = 0.f;
            sc[i] = ok ? v : NEG_INF; }
#pragma unroll
        for (int i = 0; i < 16; ++i) sp[i] = sc[i];
        ktp = kt;
    }
    IDX_STORE_PREV();
#undef IDX_STORE_PREV
}
__device__ __forceinline__ int wave_total6(int c) {
    c += __builtin_amdgcn_update_dpp(0, c, 0xB1, 0xf, 0xf, false);
    c += __builtin_amdgcn_update_dpp(0, c, 0x4E, 0xf, 0xf, false);
    c += __builtin_amdgcn_update_dpp(0, c, 0x141, 0xf, 0xf, false);
    c += __builtin_amdgcn_update_dpp(0, c, 0x140, 0xf, 0xf, false);
    return __builtin_amdgcn_readlane(c, 0) + __builtin_amdgcn_readlane(c, 16) + __builtin_amdgcn_readlane(c, 32) + __builtin_amdgcn_readlane(c, 48);
}
typedef unsigned short u16x2 __attribute__((ext_vector_type(2)));
__device__ __forceinline__ u16x2 pk_count_ge(u16x2 acc, u16x2 x, u16x2 cm1) {
    unsigned t, a = __builtin_bit_cast(unsigned, acc); const unsigned one = 0x00010001u;
    asm("v_pk_sub_u16 %0, %2, %3 clamp\n\tv_pk_min_u16 %0, %0, %4\n\tv_pk_add_u16 %1, %5, %0" : "=&v"(t), "=v"(a) : "v"(__builtin_bit_cast(unsigned, x)), "v"(__builtin_bit_cast(unsigned, cm1)), "s"(one), "1"(a));
    return __builtin_bit_cast(u16x2, a); }
__device__ __forceinline__ void idx_load(const float* Srow, int nslots, int lane, float (&lv)[34]) {
#pragma unroll
    for (int i = 0; i < 34; ++i) { const int slot = 64 * i + lane; lv[i] = Srow[slot < nslots ? slot : nslots - 1]; }
}
__device__ __forceinline__ void idx_select(float (&lv)[34], const float* next_row  , int nslots, int n_adm, LAS unsigned* mrow, LAS unsigned* wl  , int lane) {
    asm volatile("" : "+v"(lane));
    constexpr int NI = 34, NP = 20, NG = NP / 4;
    unsigned u[NI];
    const int ni = (nslots + 63) >> 6, ng = (((ni + 1) >> 1) + 3) >> 2;
#pragma unroll
    for (int i = 0; i < NI; ++i) { const int slot = 64 * i + lane; const float v = (slot < nslots) ? lv[i] : NEG_INF;
        const unsigned bits = __builtin_bit_cast(unsigned, v); u[i] = bits ^ ((bits >> 31) ? 0xffffffffu : 0x80000000u); }
    if (next_row) idx_load(next_row, nslots, lane, lv);
    const unsigned UNEG = 0x007fffffu;
    unsigned Tk = UNEG + 1u; int need = 1 << 30, nties = 0;
    const bool big = n_adm > 256;
    if (big) {
        u16x2 ph[NP];
#pragma unroll
        for (int p = 0; p < NP; ++p) ph[p] = (2 * p + 1 < NI) ? (u16x2){(unsigned short)(u[2 * p] >> 16), (unsigned short)(u[2 * p + 1] >> 16)} : (u16x2){0, 0};
        unsigned T1 = 0u;
        for (int bit = 15; bit >= 0; --bit) { const unsigned cand = T1 | (1u << bit); const unsigned short c1 = (unsigned short)(cand - 1u); const u16x2 cm1 = (u16x2){c1, c1}; u16x2 acc = (u16x2){0, 0};
#pragma unroll
            for (int gq = 0; gq < NG; ++gq) if (gq < ng) {
#pragma unroll
                for (int k = 0; k < 4; ++k) acc = pk_count_ge(acc, ph[4 * gq + k], cm1); }
            if (wave_total6((int)acc.x + (int)acc.y) >= 256) T1 = cand; }
        int cgl = 0;
#pragma unroll
        for (int i = 0; i < 33; ++i) if (i < ni) cgl += ((u[i] >> 16) > T1) ? 1 : 0;
        const int need2 = 256 - wave_total6(cgl);
        int M = 0; const unsigned long long ltm = (1ull << lane) - 1ull;
#pragma unroll
        for (int i = 0; i < 33; ++i) if (i < ni) { const bool inb = (u[i] >> 16) == T1; const unsigned long long mb = __ballot(inb);
            if (mb != 0ull) { const int pos = M + __builtin_popcountll(mb & ltm); if (inb && pos < 64) wl[pos] = u[i] & 0xffffu; M += __builtin_popcountll(mb); } }
        unsigned T2 = 0u;
        if (M <= 64) {
            const unsigned val = (lane < M) ? wl[lane] : 0u;
            for (int bit = 15; bit >= 0; --bit) { const unsigned cand = T2 | (1u << bit); if (__builtin_popcountll(__ballot(val >= cand)) >= need2) T2 = cand; }
        } else {
            u16x2 pl[NP];
    #pragma unroll
            for (int p = 0; p < NP; ++p) { unsigned short a0 = 0, a1 = 0; if (2 * p + 1 < NI) { a0 = ((u[2 * p] >> 16) == T1) ? (unsigned short)u[2 * p] : (unsigned short)0; a1 = ((u[2 * p + 1] >> 16) == T1) ? (unsigned short)u[2 * p + 1] : (unsigned short)0; } pl[p] = (u16x2){a0, a1}; }
            for (int bit = 15; bit >= 0; --bit) { const unsigned cand = T2 | (1u << bit); const unsigned short c1 = (unsigned short)(cand - 1u); const u16x2 cm1 = (u16x2){c1, c1}; u16x2 acc = (u16x2){0, 0};
    #pragma unroll
                for (int gq = 0; gq < NG; ++gq) if (gq < ng) {
    #pragma unroll
                    for (int k = 0; k < 4; ++k) acc = pk_count_ge(acc, pl[4 * gq + k], cm1); }
                if (wave_total6((int)acc.x + (int)acc.y) >= need2) T2 = cand; }
        }
        Tk = (T1 << 16) | T2;
        int cg = 0;
#pragma unroll
        for (int i = 0; i < 33; ++i) if (i < ni) cg += ((u[i] > Tk) ? 1 : 0) + ((u[i] == Tk) ? 65536 : 0);
        const int tot = wave_total6(cg);
        need = 256 - (tot & 0xffff); nties = tot >> 16;
    }
    if (!big || nties == need) {
        const unsigned Tsel = big ? Tk : UNEG + 1u;
#pragma unroll
        for (int i = 0; i < 33; ++i) if (i < ni) { const unsigned long long sb = __ballot(u[i] >= Tsel);
            if (lane == 0) { mrow[2 * i] = (unsigned)sb; mrow[2 * i + 1] = (unsigned)(sb >> 32); } }
        return;
    }
    int ties_before = 0; const unsigned long long lt = (1ull << lane) - 1ull;
#pragma unroll
    for (int i = 0; i < 33; ++i) if (i < ni) {
        const bool tie = (u[i] == Tk) && big; const unsigned long long tb = __ballot(tie);
        const int rank = ties_before + __builtin_popcountll(tb & lt); ties_before += __builtin_popcountll(tb);
        const bool sel = big ? ((u[i] > Tk) || (tie && rank < need)) : (u[i] > UNEG);
        const unsigned long long sb = __ballot(sel);
        if (lane == 0) { mrow[2 * i] = (unsigned)sb; mrow[2 * i + 1] = (unsigned)(sb >> 32); } }
}

#ifndef REP_B
#define REP_B 1
#endif
#ifndef REP_C1
#define REP_C1 1
#endif
#ifndef REP_C2
#define REP_C2 1
#endif
#ifndef REP_C3
#define REP_C3 1
#endif
constexpr int Q_BC = 768, Q_A = 512, Q_META = 1, Q_ITEMS = Q_BC + Q_A + Q_META;
__device__ __forceinline__ void attention_item(Frame& F, const AttnCtx& C, int q, int tid, int wave, int lane) {
    LAS unsigned* mask = (LAS unsigned*)(F.lds + LDS_MASK);
    float* Sws = (float*)(F.ws + WS_H) + (size_t)F.wg * 32 * SROW;
    if (q < Q_BC) { const int G8 = 7 - q / 96, rem = q % 96;
        if (rem < 32) {
#ifndef NO_B
            for (int rp = 0; rp < REP_B; ++rp) job_b(C, rem >> 2, rem & 3, G8, Sws + wave * 4096, tid, wave, lane);
#endif
        } else {
#ifndef NO_C
            const int cc = rem - 32, j = 8 * G8 + 7 - (cc >> 3), b = cc & 7;
            for (int rp = 0; rp < REP_C1; ++rp) idx_scores(C, b, j, Sws, tid, wave, lane);
            VM_WAIT(); __syncthreads();
            for (int rp = 0; rp < REP_C2; ++rp)
            { float lv[34]; const int ns = 32 * (j + 2); LAS unsigned* wl = (LAS unsigned*)(C.lds + wave * 256);
              idx_load(Sws + (size_t)(wave * 4) * SROW, ns, lane, lv);
#pragma nounroll
              for (int qq = 0; qq < 4; ++qq) { const int qi = wave * 4 + qq;
                  idx_select(lv, qq < 3 ? Sws + (size_t)(qi + 1) * SROW : (const float*)nullptr, ns, 16 + 32 * j + qi + 1, mask + qi * MASK_STRIDE, wl, lane); } }
            __syncthreads();
            for (int rp = 0; rp < REP_C3; ++rp) job_c(C, b, j, mask, tid, wave, lane);
#endif
        }
    } else if (q < Q_BC + Q_A) {
#ifndef NO_A
        const int ua = q - Q_BC; job_a(C, ua >> 6, (ua >> 5) & 1, ua & 31, tid, wave, lane);
#endif
    } else {
#ifndef NO_META
        job_a(C, 0, 0, -1, tid, wave, lane); job_a(C, 0, 1, -1, tid, wave, lane);
        job_c(C, 0, -1, mask, tid, wave, lane);
#pragma nounroll
        for (int hd = 0; hd < 4; ++hd) job_b(C, 0, hd, -1, Sws + wave * 4096, tid, wave, lane);
#endif
    }
}
__device__ __forceinline__ void attention_phase(Frame& F, int l, int rep = 0) {
    int lane_ = lane_id(), wave_ = F.wave; asm volatile("" : "+v"(lane_)); asm volatile("" : "+s"(wave_));
    const int tid_ = wave_ * 64 + lane_;
    LAS float* lut = (LAS float*)(F.lds + LDS_LUT);
    const float* table = F.in[I_TABLE];
    for (int i = tid_; i < 20 * 129; i += NWAVES * 64) { const int hd = i / 129, d = i - hd * 129; lut[hd * LUT_STRIDE + d] = table[rel_bucket(d) * 20 + hd] * LOG2E; }
    AttnCtx C; C.QKV = (const bf16*)(F.ws + WS_QKV); C.VT = (const bf16*)(F.ws + WS_VT); C.O = (bf16*)(F.ws + WS_O); C.lut = lut; C.lds = F.lds;
    C.sinks = F.in[I_SINK] + l * 8; C.subln = F.in[I_SUBLN] + l * 128;
    { const float* dl = F.in[I_DLAM] + l * 256; const float s1 = wave_sum(dl[lane_] * dl[64 + lane_]), s2 = wave_sum(dl[128 + lane_] * dl[192 + lane_]);
      C.lam_init = (l == 0) ? 0.2f : 0.35550907f; C.lam = expf(s1) - expf(s2) + C.lam_init; }
    volatile LAS unsigned* MISC = (volatile LAS unsigned*)(F.lds + LDS_MISC);
    unsigned* qctr = (unsigned*)(F.ws + WS_CTL) + 64 * (1 + l + 2 * rep);
    const int ncj = (l == 0) ? cv::JOBS_SET1 + cv::JOBS_SET0 : cv::JOBS_SET1;
    __syncthreads();
    for (;;) {
        if (tid_ == 0) MISC[16] = __hip_atomic_fetch_add(qctr, 1u, __ATOMIC_RELAXED, __HIP_MEMORY_SCOPE_AGENT);
        __syncthreads();
        const int q = (int)MISC[16];
        __syncthreads();
        if (q >= Q_ITEMS + ncj) break;
        const int grp = q >> 2, r = q & 3;
        if (r == 1 && grp < ncj) { if (grp < cv::JOBS_SET1) convert_job(F, l, 1, grp); else convert_job(F, 1, 0, grp - cv::JOBS_SET1); }
        else { const int before = grp + (r > 1), aq = q - (before < ncj ? before : ncj);
               if (aq > 0 || l == 0) attention_item(F, C, aq == 0 ? Q_ITEMS - 1 : aq - 1, tid_, wave_, lane_); }
    }
    __syncthreads();
}
template <class Sched>
__device__ __forceinline__ LAS const float* rstd_cache_fill(Frame& F, const ssq_t* ss, const Sched& S) {
    LAS float* rc = (LAS float*)(F.lds + LDS_RSC);
    pg8::Unit u0, u1, t; const bool any = S.next(0, u0); u1 = u0;
    if (any) { for (int i = 1; S.next(i, t); ++i) u1 = t; }
    const int pm0 = any ? u0.pm : -1, pm1 = (any && u1.pm != u0.pm) ? u1.pm : -1;
    int tid = F.wave * 64 + lane_id(); asm volatile("" : "+v"(tid));
    const int r = tid & 255, pm = (tid >> 8) ? pm1 : pm0;
    if (pm >= 0) rc[(tid >> 8) * 256 + r] = rstd_of(ss[pm * 256 + r]);
    if (tid == 0) { ((LAS int*)rc)[512] = pm0; ((LAS int*)rc)[513] = pm1; }
    __syncthreads();
    return rc;
}
constexpr int N_PHASES = 20;
struct GateOrder { int G, c;
    __device__ __forceinline__ bool next(int i, pg8::Unit& u) const { int t;
        if (G == 256) { const int cnt = c < 128 ? 5 : 7; if (i >= cnt) return false; t = (c < 128 ? 5 * c : 640 + 7 * (c - 128)) + i; }
        else { t = i * G + c; if (t >= 64 * 24) return false; }
        u.pm = t / 24; u.pn = t - u.pm * 24; u.seg = 0; return true; } };
struct SameTileOrder { int n; __device__ __forceinline__ bool next(int i, pg8::Unit& u) const { u.pm = 0; u.pn = 0; u.seg = 0; return i < n; } };
#ifndef REP_OUT
#define REP_OUT 1
#endif
#ifndef REP_INIT
#define REP_INIT 1
#endif
#ifndef REP_FIN
#define REP_FIN 1
#endif
#ifndef REP_META
#define REP_META 1
#endif
#ifndef REP_DN
#define REP_DN 1
#endif
#ifndef REP_BR
#define REP_BR 1
#endif
#ifndef REP_CONV
#define REP_CONV 1
#endif
#ifndef REP_ATT
#define REP_ATT 1
#endif
#ifndef REP_GU
#define REP_GU 1
#endif
#ifndef REP_IN
#define REP_IN 1
#endif
#ifndef ONLY_SITE
#define SITE_ON(k) 1
#else
#define SITE_ON(k) (ONLY_SITE == (k))
#endif
struct Args { const float* in[19]; float* out; unsigned char* ws; int ph_lo, ph_hi; };
__global__ void __launch_bounds__(NWAVES * 64, 2) fwd(Args args) {
    extern __shared__ __attribute__((aligned(16))) unsigned char lds[];
    Frame F;
    F.lds = (LAS unsigned char*)lds;
    F.wave = __builtin_amdgcn_readfirstlane((int)threadIdx.x >> 6);
    F.G = gridDim.x; F.wg = blockIdx.x; F.ws = args.ws; F.out = args.out;
#pragma unroll
    for (int i = 0; i < 19; ++i) F.in[i] = args.in[i];
    volatile LAS unsigned* MISC = (volatile LAS unsigned*)(F.lds + LDS_MISC);
    if (F.wave == 0) MISC[lane_id()] = 0u;
    __syncthreads();
    const int lo = args.ph_lo, hi = args.ph_hi;
    gu32* ctl = (gu32*)(F.ws + WS_CTL);
    XcdBarrier bar; bar.bar = (unsigned*)(ctl + CW_BAR); bar.x = 0; bar.st = nullptr; bar.wv = F.wave;
    if (hi - lo > 1) bar = xcd_barrier_post((unsigned*)(ctl + CW_BAR), MISC + 8, F.wave);
#define IN(k) (lo <= (k) && (k) < hi)
#ifndef REP_BAR
#define REP_BAR 1
#endif
#define SEAM(k) do { if (IN(k) && IN((k) + 1)) { for (int rb_ = 0; rb_ < REP_BAR; ++rb_) xcd_barrier(bar); } } while (0)
    unsigned char* const ws0 = F.ws;

    #ifndef NO_CONV
    if (IN(0)) {
#ifndef NO_INIT
        for (int rep = 0; rep < REP_INIT; ++rep) init_h(F);
#endif
#ifndef NO_CONV0
        for (int rep = 0; rep < REP_CONV; ++rep) convert_layer(F, 0, 0);
#endif
    }
#endif
    SEAM(0);
    for (int s = 0; s < 4; ++s) {
        const int l = s >> 1, f = s & 1, base = 1 + 9 * l;
        const int pg = base + 6 * f;
        unsigned char* ws = ws0; asm volatile("" : "+s"(ws));
        F.ws = ws;
        bf16* HB = (bf16*)(ws + WS_HB); bf16* GG = (bf16*)(ws + WS_GG); bf16* QKV = (bf16*)(ws + WS_QKV); bf16* Y = (bf16*)(ws + WS_QKV);
        bf16* VT = (bf16*)(ws + WS_VT); bf16* O = (bf16*)(ws + WS_O); ssq_t* SS = (ssq_t*)(ws + WS_CTL + CTL_SS);
#if SITE_ON(1)
        if (IN(pg)) for (int rep = 0; rep < REP_GU; ++rep) {
            pg8::Gemm g{HB, (const bf16*)(ws + (f ? WS_WGU2 : WS_WGU1)), D, D, D}; pg8::StaticOrder<1> S; S.init(MREAL, NGU, F.G, F.wg);
            EpiSwiGLU E{GG, (s >= FP8_DN_FROM) ? (unsigned char*)QKV : (unsigned char*)nullptr, SS + (size_t)(3 * l + 2 * f) * MP, rstd_cache_fill(F, SS + (size_t)(3 * l + 2 * f) * MP, S)};
            { MetaGU Mg{HB + (size_t)MREAL * D, g.Bt, GG, E.ss}; for (int rm = 0; rm < REP_META; ++rm) meta_gemm2<2, D / 256, 2, MetaGU>(F, Mg, (s < 3) ? FF / 16 : 0, F.wg, F.G); }
#ifdef PROBE_GU_NULL
            if (rep == 0) { EpiNull En{GG};
#if PROBE_GU_NULL == 2
                SameTileOrder S2{11};  pg8::gemm_phase<EpiNull, SameTileOrder, true>(F.lds, g, S2, En);
#else
                pg8::gemm_phase<EpiNull, pg8::StaticOrder<1>, true>(F.lds, g, S, En, F.wave);
#endif
            } else
#endif
            pg8::gemm_phase<EpiSwiGLU, pg8::StaticOrder<1>, true>(F.lds, g, S, E, F.wave);
        }
#endif
        SEAM(pg);
#if SITE_ON(2)
        if (IN(pg + 1)) for (int rep = 0; rep < REP_DN; ++rep) {
            const bool dn8 = (s >= FP8_DN_FROM);
            const bf16* Wd = (const bf16*)(ws + (f ? WS_WD2 : WS_WD1));
            pg8::StaticOrder<1> S; S.init(MREAL, D, F.G, F.wg);
            ssq_t* sso = (rep < REP_DN - 1) ? SS + (size_t)7 * MP : SS + (size_t)(3 * l + 1 + 2 * f) * MP; const float al = (rep < REP_DN - 1) ? 0.f : 0.5f;
            if (s < 3) { MetaResid Mr{GG + (size_t)MREAL * FF, FF, Wd, FF, HB, sso, al};     meta_gemm2<1, FF / 256, 1, MetaResid>(F, Mr, D / 16, F.wg, F.G); }
            if (dn8) { pg8::Gemm g{QKV, (const bf16*)(ws + (f ? WS_WD82 : WS_WD81)), FF / 2, FF / 2, FF / 2}; EpiResidF8 E{HB, sso, al / (G8_SCALE * WG8_SCALE)};
                pg8::gemm_phase<EpiResidF8, pg8::StaticOrder<1>, true>(F.lds, g, S, E, F.wave); }
            else { pg8::Gemm g{GG, Wd, FF, FF, FF}; EpiResid E{HB, sso, al};
                pg8::gemm_phase<EpiResid, pg8::StaticOrder<1>, true>(F.lds, g, S, E, F.wave); }
        }
#endif
        SEAM(pg + 1);
        if (f == 0) {
            if (IN(base + 2)) for (int rep = 0; rep < REP_IN; ++rep) {
#if SITE_ON(3)
                { const int mG = (F.G == 256) ? 128 : F.G;
                  MetaIn Mi{HB + (size_t)MREAL * D, (const bf16*)(ws + WS_WIN), QKV, (unsigned char*)GG, SS + (size_t)(3 * l + 1) * MP}; meta_gemm2<1, D / 256, 3, MetaIn>(F, Mi, NIN / 16, F.wg, mG);
                  MetaVT Mv{HB + (size_t)MREAL * D, (const bf16*)(ws + WS_WVT), VT, SS + (size_t)(3 * l + 1) * MP}; meta_gemm2<1, D / 256, 1, MetaVT>(F, Mv, NVT / 16, F.wg, mG); }
#ifndef TEST_NO_QKV
                { pg8::Gemm g{HB, (const bf16*)(ws + WS_WIN), D, D, D}; pg8::StaticOrder<1> S; S.init(MREAL, NQKV, F.G, F.wg);
                  EpiIn E{QKV, GG, SS + (size_t)(3 * l + 1) * MP, rstd_cache_fill(F, SS + (size_t)(3 * l + 1) * MP, S)};
                  pg8::gemm_phase<EpiIn, pg8::StaticOrder<1>, true>(F.lds, g, S, E, F.wave); }
#endif
#ifndef TEST_NO_G8
                { pg8::Gemm g{(const bf16*)(ws + WS_HB8), (const bf16*)(ws + WS_WG8), D / 2, D / 2, D / 2, 256};
                  GateOrder S{F.G, F.wg};
                  EpiGates8 E{(unsigned char*)GG, SS + (size_t)(3 * l + 1) * MP, rstd_cache_fill(F, SS + (size_t)(3 * l + 1) * MP, S)};
                  pg8::gemm_phase<EpiGates8, GateOrder, true>(F.lds, g, S, E, F.wave); }
#endif
#endif
#if SITE_ON(4)
                { pg8::Gemm g{(const bf16*)(ws + WS_WVT), HB, D, D, D}; pg8::StaticOrder<1> S; S.init(NVT, MREAL, F.G, (F.wg + 64) % F.G);
                  EpiVT E{VT, SS + (size_t)(3 * l + 1) * MP};
                  pg8::gemm_phase<EpiVT, pg8::StaticOrder<1>, true>(F.lds, g, S, E, F.wave); }
#endif
            }
            SEAM(base + 2);
            #ifndef NO_ATT
            if (IN(base + 3)) { for (int rep = 0; rep < REP_ATT; ++rep) attention_phase(F, l, rep); }
#endif
            SEAM(base + 3);
#if SITE_ON(5)
            if (IN(base + 4)) for (int rep = 0; rep < REP_BR; ++rep) {
                pg8::Gemm g{O, (const bf16*)(ws + WS_WBR), KBR, KBR, 512}; pg8::StaticOrder<3> S; S.init(MREAL, D, F.G, F.wg);
                EpiBr E{Y, (const unsigned char*)GG};
                if (l == 0) { MetaBr Mb{O + (size_t)MREAL * KBR, g.Bt, Y, (const unsigned char*)GG}; meta_gemm<3, MetaBr>(F, Mb, D / 16); }
                pg8::gemm_phase<EpiBr, pg8::StaticOrder<3>, true>(F.lds, g, S, E, F.wave);
            }
#endif
            SEAM(base + 4);
#if SITE_ON(6)
            if (IN(base + 5)) for (int rep = 0; rep < REP_OUT; ++rep) {
                pg8::Gemm g{Y, (const bf16*)(ws + WS_WOUT), D, D, D}; pg8::StaticOrder<1> S; S.init(MREAL, D, F.G, F.wg);
                EpiResidNo8 E{HB, (rep < REP_OUT - 1) ? SS + (size_t)7 * MP : SS + (size_t)(3 * l + 2) * MP, (rep < REP_OUT - 1) ? 0.f : 1.0f};
                if (l == 0) { MetaResid Mr{Y + (size_t)MREAL * D, D, g.Bt, D, HB, E.ssout, E.alpha}; meta_gemm2<1, D / 256, 1, MetaResid>(F, Mr, D / 16, F.wg, F.G); }
                pg8::gemm_phase<EpiResidNo8, pg8::StaticOrder<1>, true>(F.lds, g, S, E, F.wave);
            }
#endif
            SEAM(base + 5);
        }
    }
    if (IN(19)) { for (int rep = 0; rep < REP_FIN; ++rep) final_norm(F); }
#undef IN
#undef SEAM
}

#ifndef MK_SPLIT
#define MK_SPLIT 0
#endif
extern "C" void kernel_launch(void* const* d_in, const int* in_sizes, int n_in, void* d_out, int out_size, void* d_ws, size_t ws_size, hipStream_t stream) {
    static int grid = 0;
    if (grid == 0) {
        if (n_in != 19 || in_sizes[0] != MREAL * D || out_size != MREAL * D || ws_size < WS_END) { fprintf(stderr, "kernel_launch: unexpected shapes (n_in %d in0 %d out %d ws %zu need %zu)\n", n_in, n_in > 0 ? in_sizes[0] : -1, out_size, ws_size, (size_t)WS_END); grid = -1; return; }
        int dev = 0, cus = 0, per_cu = 0;
        if (hipGetDevice(&dev) != hipSuccess || hipDeviceGetAttribute(&cus, hipDeviceAttributeMultiprocessorCount, dev) != hipSuccess) { grid = -1; return; }
        if (hipFuncSetAttribute((const void*)fwd, hipFuncAttributeMaxDynamicSharedMemorySize, LDS_BYTES) != hipSuccess) { fprintf(stderr, "kernel_launch: hipFuncSetAttribute failed\n"); grid = -1; return; }
        if (hipOccupancyMaxActiveBlocksPerMultiprocessor(&per_cu, (const void*)fwd, NWAVES * 64, LDS_BYTES) != hipSuccess || per_cu < 1) fprintf(stderr, "kernel_launch: occupancy query says %d\n", per_cu);
        (void)hipGetLastError();
        grid = cus > 256 ? 256 : cus;
    }
    if (grid < 0) return;
    (void)hipMemsetAsync((char*)d_ws + WS_CTL, 0, CTL_ZERO_BYTES, stream);
    Args a{};
    for (int i = 0; i < 19; ++i) a.in[i] = (const float*)d_in[i];
    a.out = (float*)d_out; a.ws = (unsigned char*)d_ws;
#if MK_SPLIT
#ifndef MAXPH
#define MAXPH N_PHASES
#endif
    if (MAXPH == 0) { a.ph_lo = 0; a.ph_hi = 0; hipLaunchKernelGGL(fwd, dim3(grid), dim3(NWAVES * 64), LDS_BYTES, stream, a); }
    for (int p = 0; p < MAXPH; ++p) { if (p == 18) continue; a.ph_lo = p; a.ph_hi = p + 1; hipLaunchKernelGGL(fwd, dim3(grid), dim3(NWAVES * 64), LDS_BYTES, stream, a); }
#else
    a.ph_lo = 0; a.ph_hi = N_PHASES;
    hipLaunchKernelGGL(fwd, dim3(grid), dim3(NWAVES * 64), LDS_BYTES, stream, a);
#endif
    const hipError_t le = hipPeekAtLastError();
    if (le != hipSuccess) fprintf(stderr, "kernel_launch: launch failed: %s\n", hipGetErrorName(le));
}
```

```cpp
#include <hip/hip_runtime.h>
#include <cstdio>
#include <cstdint>
#ifndef MK_SPLIT
#define MK_SPLIT 0
#define MAXPH 20
#endif
__device__ __forceinline__ int lane_id() { return (int)__builtin_amdgcn_mbcnt_hi(~0u, __builtin_amdgcn_mbcnt_lo(~0u, 0u)); }
namespace pg8 {
#define PG8_LAS __attribute__((address_space(3)))
typedef unsigned short bf16_t;
typedef short bf16x8 __attribute__((ext_vector_type(8)));
typedef float f32x4 __attribute__((ext_vector_type(4)));
typedef unsigned u32x4 __attribute__((ext_vector_type(4)));
constexpr int BM = 256, BK = 64, HALF = 128, HTB = HALF * BK * 2  , STAGE_BYTES = 8 * HTB, NXCD = 8, WGM = 8;

__host__ __device__ __forceinline__ int lds_byte(int r, int c) { const int st = (r >> 4) * 2 + (c >> 5), rr = r & 15, cc = c & 31, ob = rr * 64 + cc * 2; return st * 1024 + (ob ^ (((ob >> 9) & 1) << 5)); }
__host__ __device__ __forceinline__ void stage_rc(int b, int& R, int& C) { const int st = b / 1024, sb = b % 1024, swz = sb ^ (((sb >> 9) & 1) << 5); R = (st >> 1) * 16 + swz / 64; C = (st & 1) * 32 + (swz % 64) / 2; }
__host__ __device__ __forceinline__ int perm32(int rho) { const int n = rho >> 4, i = rho & 15; return 8 * (i >> 2) + 4 * n + (i & 3); }

struct Unit { int pm, pn, seg; };
struct Gemm { const bf16_t* A; const bf16_t* Bt; int lda, ldb, Kloop; int bn_rows = 256; };

template <int NSEG> struct StaticOrder {
    int nM, nN, nwg, G, c;
    __device__ __forceinline__ void init(int M, int N, int G_, int c_) { nM = M / BM; nN = N / BM; nwg = nM * nN; G = G_; c = c_; }
    __device__ __forceinline__ bool next(int i, Unit& u) const {
        const int ti = i / NSEG; u.seg = i - ti * NSEG;
        const long L = (long)ti * G + c; if (L >= nwg) return false;
        int wgid = (int)L; { const int q = nwg / NXCD, r = nwg % NXCD, xcd = wgid % NXCD, off = wgid / NXCD; wgid = (xcd < r ? xcd * (q + 1) : r * (q + 1) + (xcd - r) * q) + off; }
        const int nig = WGM * nN, gid = wgid / nig, fm = gid * WGM, gsz = (nM - fm) < WGM ? (nM - fm) : WGM;
        u.pm = fm + ((wgid % nig) % gsz); u.pn = (wgid % nig) / gsz; return true;
    }
};

typedef int v8i32 __attribute__((ext_vector_type(8))); typedef int v4i32 __attribute__((ext_vector_type(4)));
__device__ __forceinline__ v8i32 cat8(bf16x8 a, bf16x8 b) { const v4i32 x = __builtin_bit_cast(v4i32, a), y = __builtin_bit_cast(v4i32, b); return __builtin_shufflevector(x, y, 0, 1, 2, 3, 4, 5, 6, 7); }
__device__ __forceinline__ unsigned cvt_pk_bf16(float lo, float hi) { unsigned r; asm volatile("v_cvt_pk_bf16_f32 %0, %1, %2" : "=v"(r) : "v"(lo), "v"(hi)); return r; }

template <class Epi, class Sched, bool ALIGN_EPI>
__device__ __forceinline__ void gemm_phase(PG8_LAS unsigned char* lds, const Gemm g, const Sched& S, const Epi& E, int wave_id) {
    int tid_ = wave_id * 64 + lane_id(); asm volatile("" : "+v"(tid_));
    const int tid = tid_, wid = __builtin_amdgcn_readfirstlane(tid >> 6), lane = tid & 63, wr = wid >> 2, wc = wid & 3, fr = lane & 15, fq = lane >> 4;
    const int nt = g.Kloop / BK;
    unsigned voffA[2], voffB[2];
#pragma unroll
    for (int i = 0; i < 2; ++i) { int R, C; stage_rc(tid * 16 + i * 8192, R, C); const int Rb = Epi::PERM ? ((R & ~31) + perm32(R & 31)) : R;
        voffA[i] = (unsigned)(R * g.lda + C) * 2u; voffB[i] = (unsigned)(Rb * g.ldb + C) * 2u; }
    const size_t kstep = (size_t)(BK * 2);
    const size_t hstepA = (size_t)HALF * g.lda * 2, hstepB = (size_t)HALF * g.ldb * 2;
    const size_t tstepA = 2 * hstepA, tstepB = (size_t)g.bn_rows * g.ldb * 2, sstep = (size_t)g.Kloop * 2;
    const unsigned ldsw = (unsigned)wid * 1024u;
    const int aoff = lds_byte(wr * 64 + fr, fq * 8), boff = lds_byte(wc * 32 + fr, fq * 8);
#define PG8_SA(b, h) (((b) * 2 + (h)) * HTB)
#define PG8_SB(b, h) ((4 + (b) * 2 + (h)) * HTB)
#define PG8_STAGE(bufoff, gbase, voff) do { _Pragma("unroll") for (int _i = 0; _i < 2; ++_i) \
        __builtin_amdgcn_global_load_lds((const unsigned*)((const char*)(gbase) + (voff)[_i]), (PG8_LAS unsigned*)(lds + (bufoff) + ldsw + _i * 8192), 16, 0, 0); } while (0)
#define PG8_LDA(dst, b, h) do { _Pragma("unroll") for (int m = 0; m < 4; ++m) { if constexpr (Epi::FP8) { dst##8[m].lo = *(const PG8_LAS v4i32*)(lds + PG8_SA(b, h) + aoff + m * 2048); dst##8[m].hi = *(const PG8_LAS v4i32*)(lds + PG8_SA(b, h) + aoff + m * 2048 + 1024); } \
        else { _Pragma("unroll") for (int k = 0; k < 2; ++k) dst[m][k] = *(const PG8_LAS bf16x8*)(lds + PG8_SA(b, h) + aoff + m * 2048 + k * 1024); } } } while (0)
#define PG8_LDB(dst, b, h) do { _Pragma("unroll") for (int n = 0; n < 2; ++n) { if constexpr (Epi::FP8) { dst##8[n].lo = *(const PG8_LAS v4i32*)(lds + PG8_SB(b, h) + boff + n * 2048); dst##8[n].hi = *(const PG8_LAS v4i32*)(lds + PG8_SB(b, h) + boff + n * 2048 + 1024); } \
        else { _Pragma("unroll") for (int k = 0; k < 2; ++k) dst[n][k] = *(const PG8_LAS bf16x8*)(lds + PG8_SB(b, h) + boff + n * 2048 + k * 1024); } } } while (0)
#define PG8_MMA(ai, bj, At, Bt) do { __builtin_amdgcn_s_setprio(1); _Pragma("unroll") for (int m = 0; m < 4; ++m) _Pragma("unroll") for (int n = 0; n < 2; ++n) { \
        if constexpr (Epi::FP8) asm volatile("v_mfma_f32_16x16x128_f8f6f4 %0, %1, %2, %0" : "+v"(acc[ai][bj][m][n]) : "v"(Bt##8[n]), "v"(At##8[m])); \
        else { _Pragma("unroll") for (int k = 0; k < 2; ++k) acc[ai][bj][m][n] = __builtin_amdgcn_mfma_f32_16x16x32_bf16(Bt[n][k], At[m][k], acc[ai][bj][m][n], 0, 0, 0); } } __builtin_amdgcn_s_setprio(0); } while (0)
#define PG8_WAIT_V(n) asm volatile("s_waitcnt vmcnt(" #n ")" ::: "memory")
#define PG8_WAIT_L(n) asm volatile("s_waitcnt lgkmcnt(" #n ")" ::: "memory")
#define PG8_BAR __builtin_amdgcn_s_barrier()
#define PG8_SCHED __builtin_amdgcn_sched_barrier(0)
    Unit cur, nxt; int ui = 0;
    if (!S.next(0, cur)) return;
    f32x4 acc[2][2][4][2];
#pragma unroll
    for (int a = 0; a < 2; ++a)
#pragma unroll
        for (int b = 0; b < 2; ++b)
#pragma unroll
            for (int m = 0; m < 4; ++m)
#pragma unroll
                for (int n = 0; n < 2; ++n) acc[a][b][m][n] = (f32x4){0.f, 0.f, 0.f, 0.f};
    bf16x8 At[4][2], B0[2][2], B1[2][2]; v8i32 At8[4], B08[2], B18[2];
    const char* cA = (const char*)g.A + (size_t)cur.pm * tstepA + (size_t)cur.seg * sstep; const char* cB = (const char*)g.Bt + (size_t)cur.pn * tstepB + (size_t)cur.seg * sstep;
    PG8_STAGE(PG8_SB(0, 0), cB, voffB); PG8_STAGE(PG8_SB(0, 1), cB + hstepB, voffB); PG8_STAGE(PG8_SA(0, 0), cA, voffA); PG8_STAGE(PG8_SA(0, 1), cA + hstepA, voffA);
    if (wr == 1) PG8_BAR;
    PG8_WAIT_V(2); PG8_BAR;
    PG8_STAGE(PG8_SB(1, 0), cB + kstep, voffB); PG8_STAGE(PG8_SA(1, 0), cA + kstep, voffA); PG8_STAGE(PG8_SB(1, 1), cB + hstepB + kstep, voffB);
    PG8_WAIT_V(6); PG8_BAR;
    for (;;) {
        const bool has_next = S.next(ui + 1, nxt);
        const char* nA = has_next ? (const char*)g.A + (size_t)nxt.pm * tstepA + (size_t)nxt.seg * sstep : cA; const char* nB = has_next ? (const char*)g.Bt + (size_t)nxt.pn * tstepB + (size_t)nxt.seg * sstep : cB;
        for (int t = 0; t < nt; t += 2) {
            const bool last = (t == nt - 2);
            const char* a1 = cA + (size_t)(t + 1) * kstep;
            const char* a2 = last ? nA : cA + (size_t)(t + 2) * kstep; const char* b2 = last ? nB : cB + (size_t)(t + 2) * kstep;
            const char* a3 = a2 + kstep; const char* b3 = b2 + kstep;
            PG8_LDB(B0, 0, 0); if constexpr (!Epi::NOB1) PG8_LDB(B1, 0, 1); PG8_SCHED; PG8_LDA(At, 0, 0); PG8_STAGE(PG8_SA(1, 1), a1 + hstepA, voffA);
            PG8_WAIT_V(8); PG8_WAIT_L(0); PG8_BAR; PG8_MMA(0, 0, At, B0); if constexpr (!Epi::NOB1) PG8_MMA(0, 1, At, B1); PG8_BAR; PG8_SCHED;
            PG8_LDA(At, 0, 1); PG8_STAGE(PG8_SB(0, 0), b2, voffB); PG8_STAGE(PG8_SB(0, 1), b2 + hstepB, voffB); PG8_STAGE(PG8_SA(0, 0), a2, voffA);
            PG8_WAIT_V(8); PG8_WAIT_L(0); PG8_BAR; PG8_MMA(1, 0, At, B0); if constexpr (!Epi::NOB1) PG8_MMA(1, 1, At, B1); PG8_BAR; PG8_SCHED;
            PG8_LDB(B0, 1, 0); if constexpr (!Epi::NOB1) PG8_LDB(B1, 1, 1); PG8_SCHED; PG8_LDA(At, 1, 0); PG8_STAGE(PG8_SA(0, 1), a2 + hstepA, voffA);
            PG8_WAIT_V(8); PG8_WAIT_L(0); PG8_BAR; PG8_MMA(0, 0, At, B0); if constexpr (!Epi::NOB1) PG8_MMA(0, 1, At, B1); PG8_BAR; PG8_SCHED;
            PG8_LDA(At, 1, 1); PG8_STAGE(PG8_SB(1, 0), b3, voffB); PG8_STAGE(PG8_SB(1, 1), b3 + hstepB, voffB); PG8_STAGE(PG8_SA(1, 0), a3, voffA);
            PG8_WAIT_V(8); PG8_WAIT_L(0); PG8_BAR; PG8_MMA(1, 0, At, B0); if constexpr (!Epi::NOB1) PG8_MMA(1, 1, At, B1); PG8_BAR; PG8_SCHED;
        }
        if constexpr (ALIGN_EPI) { if (wr == 0) PG8_BAR; }
        if constexpr (Epi::FP8) asm volatile("s_nop 15\n\ts_nop 15\n\ts_nop 7" ::: "memory");
        E(acc, cur, wr, wc, fr, fq);
        if (!has_next) break;
        if (nxt.seg == 0) {
#pragma unroll
        for (int a = 0; a < 2; ++a)
#pragma unroll
            for (int b = 0; b < 2; ++b)
#pragma unroll
                for (int m = 0; m < 4; ++m)
#pragma unroll
                    for (int n = 0; n < 2; ++n) acc[a][b][m][n] = (f32x4){0.f, 0.f, 0.f, 0.f};
        }
        cur = nxt; cA = nA; cB = nB; ++ui;
        if constexpr (ALIGN_EPI) { if (wr == 1) PG8_BAR; }
    }
    PG8_WAIT_V(0);
    if constexpr (!ALIGN_EPI) { if (wr == 0) PG8_BAR; }
    PG8_BAR;
#undef PG8_SA
#undef PG8_SB
#undef PG8_STAGE
#undef PG8_LDA
#undef PG8_LDB
#undef PG8_MMA
#undef PG8_WAIT_V
#undef PG8_WAIT_L
#undef PG8_BAR
#undef PG8_SCHED
}
}
constexpr int NWAVES = 8;
constexpr int D = 2048, FF = 5632, NBATCH = 8, T = 2048, MREAL = NBATCH * T, NMETA = 16, MP = 65 * 256  ;
constexpr int NGU = 2 * FF, NQKV = 2816, NGATE = 3 * D, NIN = NQKV + NGATE, NVT = 768, KBR = 1536, DIN = 9672;
constexpr float EPS = 1e-6f;
constexpr float LOG2E = 1.4426950408889634f;
constexpr int C_AQ = 0, C_AK = 512, C_BQ1 = 640, C_BQ2 = 896, C_BK1 = 1152, C_BK2 = 1408, C_CQ = 1664, C_CK = 2176, C_IQ = 2240, C_IK = 2752;
constexpr int R_AV = 0, R_BV = 128, R_CV = 640, R_IW = 704;
constexpr size_t MiB = 1u << 20;
constexpr size_t WS_CTL = 0, CTL_ZERO_BYTES = 2 * MiB;
constexpr size_t WS_WGU1 = 2 * MiB, WS_WD1 = WS_WGU1 + 44 * MiB, WS_WIN = WS_WD1 + 22 * MiB, WS_WVT = WS_WIN + 35 * MiB, WS_WBR = WS_WVT + 3 * MiB, WS_WOUT = WS_WBR + 6 * MiB,
                 WS_WGU2 = WS_WOUT + 8 * MiB, WS_WD2 = WS_WGU2 + 44 * MiB;
constexpr size_t WS_H = WS_WD2 + 22 * MiB;
constexpr size_t WS_HB = WS_H + 130 * MiB;
constexpr size_t WS_GG = WS_HB + 65 * MiB;
constexpr size_t WS_QKV = WS_GG + 195 * MiB;
constexpr size_t WS_VT = WS_QKV + 90 * MiB;
constexpr size_t WS_O = WS_VT + 25 * MiB;
constexpr size_t WS_HB8 = WS_O + 49 * MiB;
constexpr size_t WS_WG8 = WS_HB8 + 33 * MiB;
constexpr size_t WS_END = WS_WG8 + 13 * MiB;
constexpr size_t WS_WD81 = WS_H + 66 * MiB, WS_WD82 = WS_H + 78 * MiB;
#ifndef FP8_DN_FROM
#define FP8_DN_FROM 1
#endif
constexpr float G8_SCALE = 16.f;
constexpr float WG8_SCALE = 64.f;
static_assert(WS_WD1 - WS_WGU1 >= (size_t)NGU * D * 2 && WS_WIN - WS_WD1 >= (size_t)D * FF * 2 && WS_WVT - WS_WIN >= (size_t)NIN * D * 2 && WS_WBR - WS_WVT >= (size_t)NVT * D * 2 &&
              WS_WOUT - WS_WBR >= (size_t)D * KBR * 2 && WS_WGU2 - WS_WOUT >= (size_t)D * D * 2, "weight map");
static_assert(WS_HB - WS_H >= (size_t)MP * D * 4 && WS_GG - WS_HB >= (size_t)MP * D * 2 && WS_GG - WS_HB >= (size_t)256 * 32 * 2080 * 4 && WS_QKV - WS_GG >= (size_t)MP * NGATE * 2 &&
              WS_VT - WS_QKV >= (size_t)MP * NQKV * 2 && WS_O - WS_VT >= (size_t)NVT * MP * 2 && WS_HB8 - WS_O >= (size_t)MP * KBR * 2 && WS_WG8 - WS_HB8 >= (size_t)MP * D && WS_END - WS_WG8 >= (size_t)NGATE * D, "activation map");
constexpr int CW_TMO = 0, CW_CODE = 1, CW_BAR = 4096;
constexpr size_t CTL_SS = 65536;
static_assert(CTL_SS + 8 * (size_t)MP * 8 <= CTL_ZERO_BYTES, "ctl");
typedef unsigned long long ssq_t;
constexpr float SS_SCALE = 16777216.f;
constexpr int SROW = 2080;
constexpr int RING_BYTES = 131072;
constexpr int LDS_LUT = 131072, LUT_STRIDE = 132, LDS_MASK = LDS_LUT + 20 * LUT_STRIDE * 4  , MASK_STRIDE = 67, LDS_MISC = LDS_MASK + 32 * MASK_STRIDE * 4  ;
constexpr int LDS_BYTES = LDS_MISC + 256;
static_assert(LDS_BYTES <= 160 * 1024, "lds");

#define GAS __attribute__((address_space(1)))
#define LAS __attribute__((address_space(3)))
typedef unsigned short bf16;
typedef unsigned v4u __attribute__((ext_vector_type(4)));
typedef unsigned v2u __attribute__((ext_vector_type(2)));
typedef float f32x4 __attribute__((ext_vector_type(4)));
typedef float f32x16 __attribute__((ext_vector_type(16)));
typedef short bf16x8 __attribute__((ext_vector_type(8)));
typedef GAS unsigned gu32;
#define RLX_AGENT __ATOMIC_RELAXED, __HIP_MEMORY_SCOPE_AGENT
#define LDS_WAIT() asm volatile("s_waitcnt lgkmcnt(0)" ::: "memory")
#define VM_WAIT() asm volatile("s_waitcnt vmcnt(0)" ::: "memory")
__device__ __forceinline__ unsigned f2bf(float f) { unsigned u = __builtin_bit_cast(unsigned, f); return (u + 0x7fffu + ((u >> 16) & 1u)) >> 16; }
__device__ __forceinline__ unsigned pk2(float lo, float hi) { return f2bf(lo) | (f2bf(hi) << 16); }
__device__ __forceinline__ float clamp8(float v) { return __builtin_amdgcn_fmed3f(v, -448.f, 448.f); }
__device__ __forceinline__ unsigned pk_fp8x4(float a, float b, float c, float d) { unsigned w = 0u; a = clamp8(a); b = clamp8(b); c = clamp8(c); d = clamp8(d); w = (unsigned)__builtin_amdgcn_cvt_pk_fp8_f32(a, b, (int)w, false); w = (unsigned)__builtin_amdgcn_cvt_pk_fp8_f32(c, d, (int)w, true); return w; }
__device__ __forceinline__ float bf_lo(unsigned w) { return __builtin_bit_cast(float, w << 16); }
__device__ __forceinline__ float bf_hi(unsigned w) { return __builtin_bit_cast(float, w & 0xffff0000u); }
__device__ __forceinline__ float fast_exp2(float x) { return __builtin_amdgcn_exp2f(x); }
__device__ __forceinline__ float fast_rcp(float x) { return __builtin_amdgcn_rcpf(x); }
__device__ __forceinline__ float sigmoidf_(float x) { return fast_rcp(1.f + fast_exp2(-x * LOG2E)); }
__device__ __forceinline__ float rstd_of(ssq_t ss) { return rsqrtf((float)ss * (1.0f / (16777216.f * D)) + EPS); }
__device__ __forceinline__ ssq_t ss_fix(float v) { return (ssq_t)(v * SS_SCALE + 0.5f); }

using pg8::Unit; using pg8::cvt_pk_bf16;
typedef f32x4 AccT[2][2][4][2];
constexpr int LDS_RSC = 131072;
struct RsCache { LAS const float* rc; int slot;
    __device__ __forceinline__ RsCache(LAS const float* rc_, int pm) : rc(rc_) { const int t0 = ((LAS const int*)rc_)[512], t1 = ((LAS const int*)rc_)[513]; slot = (pm == t0) ? 0 : ((pm == t1) ? 256 : -1); }
    __device__ __forceinline__ float get(const ssq_t* ss, int row) const { return slot >= 0 ? rc[slot + (row & 255)] : rstd_of(ss[row]); } };
struct EpiSwiGLU {
    static constexpr bool PERM = true, FP8 = false, NOB1 = false;
    bf16* G; unsigned char* G8; const ssq_t* ss; LAS const float* rc;
    __device__ __forceinline__ void operator()(AccT& acc, const Unit& u, int wr, int wc, int fr, int fq) const {
        const int row0 = u.pm * 256 + wr * 64 + fr, col0 = u.pn * 128 + wc * 32 + 8 * fq; const RsCache R(rc, u.pm);
#pragma unroll
        for (int ai = 0; ai < 2; ++ai)
#pragma unroll
            for (int m = 0; m < 4; ++m) { const int row = row0 + ai * 128 + m * 16; const float rs = R.get(ss, row), k1 = -rs * LOG2E, k2 = rs * rs * (G8 ? G8_SCALE : 1.f);
                float o[8];
#pragma unroll
                for (int n = 0; n < 2; ++n) { const f32x4 ag = acc[ai][0][m][n], au = acc[ai][1][m][n];
                    f32x4 e = ag * k1;
#pragma unroll
                    for (int j = 0; j < 4; ++j) e[j] = fast_exp2(e[j]);
                    f32x4 d = e + 1.f;
#pragma unroll
                    for (int j = 0; j < 4; ++j) d[j] = fast_rcp(d[j]);
                    const f32x4 o4 = (ag * au) * (d * k2);
#pragma unroll
                    for (int j = 0; j < 4; ++j) o[4 * n + j] = o4[j]; }
                if (G8) { v2u w; w.x = pk_fp8x4(o[0], o[1], o[2], o[3]); w.y = pk_fp8x4(o[4], o[5], o[6], o[7]);
                    *(v2u*)(G8 + (size_t)row * FF + col0) = w; }
                else { v4u w; w.x = cvt_pk_bf16(o[0], o[1]); w.y = cvt_pk_bf16(o[2], o[3]); w.z = cvt_pk_bf16(o[4], o[5]); w.w = cvt_pk_bf16(o[6], o[7]);
                    *(v4u*)(G + (size_t)row * FF + col0) = w; } }
    }
};
template <bool W8, bool F8> struct EpiResidT {
    static constexpr bool PERM = true, FP8 = F8, NOB1 = false;
    bf16* HB; ssq_t* ssout; float alpha;
    __device__ __forceinline__ void operator()(AccT& acc, const Unit& u, int wr, int wc, int fr, int fq) const {
        const int row0 = u.pm * 256 + wr * 64 + fr, colb = u.pn * 256 + wc * 32 + 8 * fq;
        GAS unsigned char* hbg = (GAS unsigned char*)HB; const unsigned e00 = (unsigned)row0 * D + colb;
        v4u hv[2][4][2];
#pragma unroll
        for (int ai = 0; ai < 2; ++ai)
#pragma unroll
            for (int m = 0; m < 4; ++m)
#pragma unroll
                for (int bj = 0; bj < 2; ++bj) hv[ai][m][bj] = *(const GAS v4u*)(hbg + (e00 + (unsigned)((ai * 128 + m * 16) * D + bj * 128)) * 2u);
#pragma unroll
        for (int ai = 0; ai < 2; ++ai) {
#pragma unroll
            for (int m = 0; m < 4; ++m) { const int row = row0 + ai * 128 + m * 16; float part = 0.f;
#pragma unroll
                for (int bj = 0; bj < 2; ++bj) { const unsigned off = e00 + (unsigned)((ai * 128 + m * 16) * D + bj * 128); const v4u o = hv[ai][m][bj];
                    f32x4 h0, h1;
                    h0[0] = __builtin_bit_cast(float, o.x << 16); h0[1] = __builtin_bit_cast(float, o.x & 0xffff0000u); h0[2] = __builtin_bit_cast(float, o.y << 16); h0[3] = __builtin_bit_cast(float, o.y & 0xffff0000u);
                    h1[0] = __builtin_bit_cast(float, o.z << 16); h1[1] = __builtin_bit_cast(float, o.z & 0xffff0000u); h1[2] = __builtin_bit_cast(float, o.w << 16); h1[3] = __builtin_bit_cast(float, o.w & 0xffff0000u);
                    h0 = h0 + acc[ai][bj][m][0] * alpha; h1 = h1 + acc[ai][bj][m][1] * alpha;
                    v4u w; w.x = cvt_pk_bf16(h0[0], h0[1]); w.y = cvt_pk_bf16(h0[2], h0[3]); w.z = cvt_pk_bf16(h1[0], h1[1]); w.w = cvt_pk_bf16(h1[2], h1[3]);
                    *(GAS v4u*)(hbg + off * 2u) = w;
                    if constexpr (W8) { v2u w8v; w8v.x = pk_fp8x4(h0[0], h0[1], h0[2], h0[3]); w8v.y = pk_fp8x4(h1[0], h1[1], h1[2], h1[3]); *(GAS v2u*)(hbg + (WS_HB8 - WS_HB) + off) = w8v; }
                    part += (h0[0] * h0[0] + h0[1] * h0[1]) + (h0[2] * h0[2] + h0[3] * h0[3]) + (h1[0] * h1[0] + h1[1] * h1[1]) + (h1[2] * h1[2] + h1[3] * h1[3]); }
                part += __shfl_xor(part, 16); part += __shfl_xor(part, 32);
                if (fq == 0) atomicAdd(ssout + row, ss_fix(part)); }
            asm volatile("" ::: "memory"); }
    }
};
typedef EpiResidT<true, false> EpiResid; typedef EpiResidT<true, true> EpiResidF8; typedef EpiResidT<false, false> EpiResidNo8;
struct EpiIn {
    static constexpr bool PERM = true, FP8 = false, NOB1 = false;
    bf16* QKV; bf16* GATES; const ssq_t* ss; LAS const float* rc;
    __device__ __forceinline__ void operator()(AccT& acc, const Unit& u, int wr, int wc, int fr, int fq) const {
        const int row0 = u.pm * 256 + wr * 64 + fr; const bool isg = u.pn >= NQKV / 256; const RsCache R(rc, u.pm);
        bf16* base = isg ? GATES : QKV; const int ld = isg ? NGATE : NQKV; const int colb = (isg ? (u.pn - NQKV / 256) : u.pn) * 256 + wc * 32 + 8 * fq;
#pragma unroll
        for (int ai = 0; ai < 2; ++ai)
#pragma unroll
            for (int m = 0; m < 4; ++m) { const int row = row0 + ai * 128 + m * 16; const float rs = R.get(ss, row);
#pragma unroll
                for (int bj = 0; bj < 2; ++bj) { f32x4 v0 = acc[ai][bj][m][0] * rs, v1 = acc[ai][bj][m][1] * rs;
                    if (isg) {
#pragma unroll
                        for (int j = 0; j < 4; ++j) { v0[j] = sigmoidf_(v0[j]); v1[j] = sigmoidf_(v1[j]); } }
                    v4u w; w.x = cvt_pk_bf16(v0[0], v0[1]); w.y = cvt_pk_bf16(v0[2], v0[3]); w.z = cvt_pk_bf16(v1[0], v1[1]); w.w = cvt_pk_bf16(v1[2], v1[3]);
                    *(v4u*)(base + (size_t)row * ld + colb + bj * 128) = w; } }
    }
};
__device__ __forceinline__ float gate_code(float x) { return fmaxf(__builtin_rintf(sigmoidf_(x) * 255.f), 1.f); }
__device__ __forceinline__ float gate_code_k(float a, float k) { return fmaxf(__builtin_rintf(fast_rcp(__builtin_fmaf(fast_exp2(a * k), 1.f / 255.f, 1.f / 255.f))), 1.f); }
__device__ __forceinline__ unsigned pack_u8x4(float a, float b, float c, float d) {
    unsigned w = 0u; w = __builtin_amdgcn_cvt_pk_u8_f32(a, 0u, w); w = __builtin_amdgcn_cvt_pk_u8_f32(b, 1u, w); w = __builtin_amdgcn_cvt_pk_u8_f32(c, 2u, w); w = __builtin_amdgcn_cvt_pk_u8_f32(d, 3u, w); return w; }
struct EpiGates8 {
    static constexpr bool PERM = true, FP8 = true, NOB1 = false;
    unsigned char* GATES; const ssq_t* ss; LAS const float* rc;
    __device__ __forceinline__ void operator()(AccT& acc, const Unit& u, int wr, int wc, int fr, int fq) const {
        const int row0 = u.pm * 256 + wr * 64 + fr, colb = u.pn * 256 + wc * 32 + 8 * fq; const RsCache R(rc, u.pm);
        GAS unsigned char* gg = (GAS unsigned char*)GATES; const unsigned e00 = (unsigned)row0 * NGATE + colb;
#pragma unroll
        for (int ai = 0; ai < 2; ++ai)
#pragma unroll
            for (int m = 0; m < 4; ++m) { const int row = row0 + ai * 128 + m * 16; const float k = R.get(ss, row) * (-LOG2E / WG8_SCALE);
#pragma unroll
                for (int bj = 0; bj < 2; ++bj) { const f32x4 v0 = acc[ai][bj][m][0], v1 = acc[ai][bj][m][1];
                    v2u w; w.x = pack_u8x4(gate_code_k(v0[0], k), gate_code_k(v0[1], k), gate_code_k(v0[2], k), gate_code_k(v0[3], k)); w.y = pack_u8x4(gate_code_k(v1[0], k), gate_code_k(v1[1], k), gate_code_k(v1[2], k), gate_code_k(v1[3], k));
                    *(GAS v2u*)(gg + e00 + (unsigned)((ai * 128 + m * 16) * NGATE + bj * 128)) = w; } }
    }
};
struct EpiVT {
    static constexpr bool PERM = true, FP8 = false, NOB1 = false;
    bf16* VT; const ssq_t* ss;
    __device__ __forceinline__ void operator()(AccT& acc, const Unit& u, int wr, int wc, int fr, int fq) const {
        const int row0 = u.pm * 256 + wr * 64 + fr, colb = u.pn * 256 + wc * 32 + 8 * fq;
        float rs[2][8];
#pragma unroll
        for (int bj = 0; bj < 2; ++bj)
#pragma unroll
            for (int j = 0; j < 8; ++j) rs[bj][j] = rstd_of(ss[colb + bj * 128 + j]);
#pragma unroll
        for (int ai = 0; ai < 2; ++ai)
#pragma unroll
            for (int m = 0; m < 4; ++m) { const int row = row0 + ai * 128 + m * 16;
#pragma unroll
                for (int bj = 0; bj < 2; ++bj) { const f32x4 a0 = acc[ai][bj][m][0], a1 = acc[ai][bj][m][1];
                    v4u w; w.x = cvt_pk_bf16(a0[0] * rs[bj][0], a0[1] * rs[bj][1]); w.y = cvt_pk_bf16(a0[2] * rs[bj][2], a0[3] * rs[bj][3]);
                    w.z = cvt_pk_bf16(a1[0] * rs[bj][4], a1[1] * rs[bj][5]); w.w = cvt_pk_bf16(a1[2] * rs[bj][6], a1[3] * rs[bj][7]);
                    *(v4u*)(VT + (size_t)row * MP + colb + bj * 128) = w; } }
    }
};
struct EpiBr {
    static constexpr bool PERM = true, FP8 = false, NOB1 = false;
    bf16* Y; const unsigned char* GATES;
    __device__ __forceinline__ void operator()(AccT& acc, const Unit& u, int wr, int wc, int fr, int fq) const {
        const int row0 = u.pm * 256 + wr * 64 + fr, colb = u.pn * 256 + wc * 32 + 8 * fq; const int seg = u.seg;
        GAS const unsigned char* gg = (GAS const unsigned char*)GATES; const unsigned g00 = (unsigned)row0 * NGATE + colb + (unsigned)(seg * D);
        GAS unsigned char* yg = (GAS unsigned char*)Y; const unsigned y00 = ((unsigned)row0 * D + colb) * 2u;
        v2u gn[2][4][2], gd[2][4][2];
#pragma unroll
        for (int ai = 0; ai < 2; ++ai)
#pragma unroll
            for (int m = 0; m < 4; ++m)
#pragma unroll
                for (int bj = 0; bj < 2; ++bj) { const unsigned o = g00 + (unsigned)((ai * 128 + m * 16) * NGATE + bj * 128);
                    gn[ai][m][bj] = *(GAS const v2u*)(gg + o); gd[ai][m][bj] = (seg < 2) ? *(GAS const v2u*)(gg + o + D) : (v2u){0x01010101u, 0x01010101u}; }
        const float sc = (seg < 2) ? 1.f : (1.f / 255.f);
#pragma unroll
        for (int ai = 0; ai < 2; ++ai)
#pragma unroll
            for (int m = 0; m < 4; ++m)
#pragma unroll
                for (int bj = 0; bj < 2; ++bj) { const v2u n = gn[ai][m][bj], d = gd[ai][m][bj];
                    f32x4 v0 = acc[ai][bj][m][0], v1 = acc[ai][bj][m][1];
#pragma unroll
                    for (int j = 0; j < 4; ++j) { v0[j] *= (float)((n.x >> (8 * j)) & 0xffu) * sc * fast_rcp((float)((d.x >> (8 * j)) & 0xffu)); v1[j] *= (float)((n.y >> (8 * j)) & 0xffu) * sc * fast_rcp((float)((d.y >> (8 * j)) & 0xffu)); }
                    acc[ai][bj][m][0] = v0; acc[ai][bj][m][1] = v1;
                    if (seg == 2) { v4u w; w.x = cvt_pk_bf16(v0[0], v0[1]); w.y = cvt_pk_bf16(v0[2], v0[3]); w.z = cvt_pk_bf16(v1[0], v1[1]); w.w = cvt_pk_bf16(v1[2], v1[3]);
                        *(GAS v4u*)(yg + y00 + (unsigned)((ai * 128 + m * 16) * D + bj * 128) * 2u) = w; } }
    }
};

struct EpiNull {
    static constexpr bool PERM = true, FP8 = false, NOB1 = false;
    bf16* G;
    __device__ __forceinline__ void operator()(AccT& acc, const Unit& u, int wr, int wc, int fr, int fq) const {
        float s = 0.f;
#pragma unroll
        for (int ai = 0; ai < 2; ++ai)
#pragma unroll
            for (int bj = 0; bj < 2; ++bj)
#pragma unroll
                for (int m = 0; m < 4; ++m)
#pragma unroll
                    for (int n = 0; n < 2; ++n) s += acc[ai][bj][m][n][0] + acc[ai][bj][m][n][1] + acc[ai][bj][m][n][2] + acc[ai][bj][m][n][3];
        if (s == 12345.678f) G[0] = 1;
    }
};
#define XB_TMO      128
#define XB_XCNT(j)  (256  + 64 * (j))
#define XB_XSUB(j)  (1280 + 64 * (j))
#define XB_XGEN(j)  (2304 + 64 * (j))
#define XB_TOP      3328
#define XB_TOPGEN   3392
#define XCD_BAR_WORDS 3456
#define XB_SPIN_CAP (1u << 18)
__device__ __forceinline__ unsigned xb_ld(unsigned* p)              { return __hip_atomic_load(p, __ATOMIC_RELAXED, __HIP_MEMORY_SCOPE_AGENT); }
__device__ __forceinline__ unsigned xb_add(unsigned* p, unsigned v) { return __hip_atomic_fetch_add(p, v, __ATOMIC_RELAXED, __HIP_MEMORY_SCOPE_AGENT); }
__device__ __forceinline__ unsigned xb_xcc_id() { return (unsigned)__builtin_amdgcn_s_getreg((3 << 11) | 20) & 0xFu; }
#define XB_SPIN(cond, bar) do { unsigned _sp = 0; while (cond) { __builtin_amdgcn_s_sleep(1); \
    if ((++_sp & 255u) == 0u) { if (xb_ld(&(bar)[XB_TMO])) break; if (_sp > XB_SPIN_CAP) { atomicAdd(&(bar)[XB_TMO], 1u); break; } } } } while (0)
struct XcdBarrier { unsigned* bar; unsigned x; volatile LAS unsigned* st; int wv; };
__device__ __forceinline__ XcdBarrier xcd_barrier_post(unsigned* bar, volatile LAS unsigned* st, int wv) {
    XcdBarrier b; b.bar = bar; b.x = xb_xcc_id(); b.st = st; b.wv = wv;
    if (wv == 0 && lane_id() == 0) (void)xb_add(&bar[XB_XCNT(b.x)], 1u);
    return b;
}
__device__ __forceinline__ void xcd_barrier_complete(unsigned* bar, unsigned x, unsigned& nloc, unsigned& nx) {
    const unsigned G = gridDim.x * gridDim.y * gridDim.z;
    unsigned sum, cnt, mine, sp = 0u;
    for (;;) {
        sum = 0u; cnt = 0u; mine = 0u;
#pragma unroll
        for (unsigned j = 0; j < 16; ++j) { const unsigned c = xb_ld(&bar[XB_XCNT(j)]); sum += c; cnt += (c > 0u) ? 1u : 0u; mine = (j == x) ? c : mine; }
        if (sum == G) break;
        __builtin_amdgcn_s_sleep(1);
        if ((++sp & 255u) == 0u) { if (xb_ld(&bar[XB_TMO])) break; if (sp > XB_SPIN_CAP) { atomicAdd(&bar[XB_TMO], 1u); break; } }
    }
    nloc = mine > 0u ? mine : 1u; nx = cnt > 0u ? cnt : 1u;
}
__device__ __forceinline__ void xcd_barrier(const XcdBarrier& b) {
    asm volatile("s_waitcnt vmcnt(0)" ::: "memory");
    __syncthreads();
    if (b.wv == 0 && lane_id() == 0) {
        unsigned* bar = b.bar;
        __builtin_amdgcn_s_waitcnt(0);
        unsigned nloc = b.st[0], nx = b.st[1];
        if (nloc == 0u) { xcd_barrier_complete(bar, b.x, nloc, nx); b.st[0] = nloc; b.st[1] = nx; }
        const unsigned old = xb_add(&bar[XB_XSUB(b.x)], 1u);
        const unsigned gen = old / nloc;
        if (old + 1u == (gen + 1u) * nloc) {
            __builtin_amdgcn_fence(__ATOMIC_RELEASE, "agent");
            asm volatile("s_waitcnt vmcnt(0)" ::: "memory");
            const unsigned og = xb_add(&bar[XB_TOP], 1u);
            const unsigned tg = og / nx;
            if (og + 1u == (tg + 1u) * nx) xb_add(&bar[XB_TOPGEN], 1u);
            else XB_SPIN(xb_ld(&bar[XB_TOPGEN]) == tg, bar);
            __builtin_amdgcn_fence(__ATOMIC_ACQUIRE, "agent");
            xb_add(&bar[XB_XGEN(b.x)], 1u);
            asm volatile("s_waitcnt vmcnt(0)" ::: "memory");
        } else {
            XB_SPIN(xb_ld(&bar[XB_XGEN(b.x)]) == gen, bar);
            __builtin_amdgcn_fence(__ATOMIC_ACQUIRE, "agent");
            asm volatile("s_waitcnt vmcnt(0)" ::: "memory");
        }
    }
    __syncthreads();
}

struct Frame {
    LAS unsigned char* lds;
    int wave, G, wg;
    unsigned char* ws;
    const float* in[19];
    float* out;
};
__device__ __forceinline__ float wave_sum(float v) {
#pragma unroll
    for (int o = 1; o < 64; o <<= 1) v += __shfl_xor(v, o);
    return v;
}
enum { I_X = 0, I_META, I_TABLE, I_NF1, I_F1G, I_F1U, I_F1D, I_NMIX, I_WIN, I_SINK, I_DLAM, I_SUBLN, I_WBR, I_WOUT, I_NF2, I_F2G, I_F2U, I_F2D, I_NFIN };

typedef float f32x2c __attribute__((ext_vector_type(2)));
struct ConvItem { const float* sp; int pitch; const float* gain; bf16* WT; int K, drow0, k0; unsigned char* W8; int drow8; };
__device__ __forceinline__ void conv_load(const ConvItem& I, f32x2c (&v)[32]) {
#pragma unroll
    for (int i = 0; i < 32; ++i) v[i] = __builtin_nontemporal_load((const f32x2c*)(I.sp + (size_t)(2 * i) * I.pitch));
}
__device__ __forceinline__ void conv_to_lds(const f32x2c (&v)[32], LAS float* scr, int lane) {
#pragma unroll
    for (int i = 0; i < 32; ++i) { LAS float* d = scr + (2 * i + (lane >> 5)) * 65 + 2 * (lane & 31); d[0] = v[i].x; d[1] = v[i].y; }
}
__device__ __forceinline__ void conv_store(const ConvItem& I, LAS float* scr, int lane) {
    const int c = lane & 7;
    f32x4 g0 = (f32x4){1.f, 1.f, 1.f, 1.f}, g1 = g0;
    if (I.gain) { g0 = *(const f32x4*)(I.gain + I.k0 + 8 * c); g1 = *(const f32x4*)(I.gain + I.k0 + 8 * c + 4); }
    LDS_WAIT(); asm volatile("" ::: "memory");
#pragma unroll
    for (int j = 0; j < 8; ++j) { const int n = (lane >> 3) + 8 * j; const LAS float* s = scr + (8 * c) * 65 + n;
        const float e0 = s[0 * 65] * g0[0], e1 = s[1 * 65] * g0[1], e2 = s[2 * 65] * g0[2], e3 = s[3 * 65] * g0[3], e4 = s[4 * 65] * g1[0], e5 = s[5 * 65] * g1[1], e6 = s[6 * 65] * g1[2], e7 = s[7 * 65] * g1[3];
        v4u o; o.x = pk2(e0, e1); o.y = pk2(e2, e3); o.z = pk2(e4, e5); o.w = pk2(e6, e7);
        *(GAS v4u*)(I.WT + (size_t)(I.drow0 + n) * I.K + I.k0 + 8 * c) = o;
        if (I.W8) { v2u o8; o8.x = pk_fp8x4(e0 * WG8_SCALE, e1 * WG8_SCALE, e2 * WG8_SCALE, e3 * WG8_SCALE); o8.y = pk_fp8x4(e4 * WG8_SCALE, e5 * WG8_SCALE, e6 * WG8_SCALE, e7 * WG8_SCALE);
            *(GAS v2u*)(I.W8 + (size_t)(I.drow8 + n) * I.K + I.k0 + 8 * c) = o8; }
    }
    LDS_WAIT(); asm volatile("" ::: "memory");
}
__device__ __forceinline__ int win_src_col(int n) {
    if (n < 640) return n;
    if (n < 1664) return n - 640 + 768;
    if (n < 2240) return n - 1664 + 2304;
    if (n < 2816) return n - 2240 + 2944;
    return n - 2816 + 3528;
}
__device__ __forceinline__ int wvt_src_col(int n) {
    if (n < 128) return n + 640;
    if (n < 640) return n - 128 + 1792;
    if (n < 704) return n - 640 + 2880;
    return n - 704 + 3520;
}
namespace cv {
constexpr int I_GU = (D / 64) * (NGU / 64), I_DN = (FF / 64) * (D / 64), I_IN = (D / 64) * (NIN / 64), I_VT = (D / 64) * (NVT / 64), I_BR = (KBR / 64) * (D / 64), I_OUT = (D / 64) * (D / 64);
constexpr int E0 = I_GU, E1 = E0 + I_DN, E2 = E1 + I_GU, E3 = E2 + I_DN, E4 = E3 + I_IN, E5 = E4 + I_VT, E6 = E5 + I_BR, NITEMS = E6 + I_OUT;
constexpr int N_SET0 = E1 + (E5 - E3), N_SET1 = (E3 - E1) + (NITEMS - E5);
constexpr int JOB_ITEMS = 63;
constexpr int JOBS_SET0 = (N_SET0 + JOB_ITEMS - 1) / JOB_ITEMS, JOBS_SET1 = (N_SET1 + JOB_ITEMS - 1) / JOB_ITEMS;
}
__device__ __forceinline__ void convert_range(Frame& F, int l, int set, int v0, int vend, int vstride) {
    using namespace cv;
    int lane_ = lane_id(), wave_ = F.wave; asm volatile("" : "+v"(lane_)); asm volatile("" : "+s"(wave_));
    LAS float* scr = (LAS float*)(F.lds + wave_ * 16896);
    unsigned char* ws = F.ws;
    auto decode = [&](int v) -> ConvItem {
        const int it = (set == 0) ? (v < E1 ? v : v - E1 + E3) : (v < E3 - E1 ? v + E1 : v - (E3 - E1) + E5);
        const int m = (it >= E0) + (it >= E1) + (it >= E2) + (it >= E3) + (it >= E4) + (it >= E5) + (it >= E6);
        const int r = it - (m == 0 ? 0 : m == 1 ? E0 : m == 2 ? E1 : m == 3 ? E2 : m == 4 ? E3 : m == 5 ? E4 : m == 6 ? E5 : E6);
        const bool isgu = (m == 0 || m == 2), isdn = (m == 1 || m == 3);
        const int K = isdn ? FF : (m == 6 ? KBR : D);
        const int ndst = isgu ? NGU : (m == 4 ? NIN : (m == 5 ? NVT : D));
        const int nblk = ndst / 64, kb = r / nblk, nb = r - kb * nblk, n0 = nb * 64;
        const float* src; int pitch; const float* gain = nullptr; size_t dst;
        if (isgu) { const int tile = n0 >> 8, within = n0 & 255; const float* Wg = (m == 0) ? F.in[I_F1G] : F.in[I_F2G]; const float* Wu = (m == 0) ? F.in[I_F1U] : F.in[I_F2U];
            src = (within < 128 ? Wg : Wu) + (size_t)l * D * FF + tile * 128 + (within & 127); pitch = FF; gain = ((m == 0) ? F.in[I_NF1] : F.in[I_NF2]) + l * D; dst = (m == 0) ? WS_WGU1 : WS_WGU2; }
        else if (isdn) { src = ((m == 1) ? F.in[I_F1D] : F.in[I_F2D]) + (size_t)l * FF * D + n0; pitch = D; dst = (m == 1) ? WS_WD1 : WS_WD2; }
        else if (m == 4) { src = F.in[I_WIN] + (size_t)l * D * DIN + win_src_col(n0); pitch = DIN; gain = F.in[I_NMIX] + l * D; dst = WS_WIN; }
        else if (m == 5) { src = F.in[I_WIN] + (size_t)l * D * DIN + wvt_src_col(n0); pitch = DIN; gain = F.in[I_NMIX] + l * D; dst = WS_WVT; }
        else if (m == 6) { src = F.in[I_WBR] + (size_t)l * KBR * D + n0; pitch = D; dst = WS_WBR; }
        else { src = F.in[I_WOUT] + (size_t)l * D * D + n0; pitch = D; dst = WS_WOUT; }
        const bool g8 = ((m == 4) && (n0 >= NQKV)) || isdn;
        ConvItem I; I.sp = src + (size_t)(kb * 64 + (lane_ >> 5)) * pitch + 2 * (lane_ & 31); I.pitch = pitch; I.gain = gain; I.WT = (bf16*)(ws + dst); I.K = K; I.drow0 = n0; I.k0 = kb * 64;
        I.W8 = g8 ? ws + (isdn ? (m == 1 ? WS_WD81 : WS_WD82) : WS_WG8) : nullptr; I.drow8 = isdn ? n0 : n0 - NQKV; return I; };
    if (v0 < vend) {
        ConvItem cur = decode(v0); f32x2c v[32]; conv_load(cur, v);
        for (int it = v0; it < vend; it += vstride) {
            conv_to_lds(v, scr, lane_);
            const bool hn = it + vstride < vend; ConvItem nxt = cur;
            if (hn) { nxt = decode(it + vstride); conv_load(nxt, v); }
            conv_store(cur, scr, lane_);
            cur = nxt;
        }
    }
}
__device__ __forceinline__ void convert_layer(Frame& F, int l, int set) {
    convert_range(F, l, set, F.wg * NWAVES + F.wave, set == 0 ? cv::N_SET0 : cv::N_SET1, F.G * NWAVES);
}
__device__ __forceinline__ void convert_job(Frame& F, int l, int set, int j) {
    const int n = set == 0 ? cv::N_SET0 : cv::N_SET1, b = j * cv::JOB_ITEMS, e = b + cv::JOB_ITEMS < n ? b + cv::JOB_ITEMS : n;
    if (F.wave < 7) convert_range(F, l, set, b + F.wave, e, 7);
}
__device__ __forceinline__ void init_h(Frame& F) {
    int lane_ = lane_id(), wave_ = F.wave; asm volatile("" : "+v"(lane_)); asm volatile("" : "+s"(wave_));
    const int gw = F.wg * NWAVES + wave_, NGW = F.G * NWAVES;
    bf16* HB = (bf16*)(F.ws + WS_HB); ssq_t* ss0 = (ssq_t*)(F.ws + WS_CTL + CTL_SS);
    for (int row0 = gw; row0 < MP; row0 += 2 * NGW) {
        f32x4 v[2][8];
#pragma unroll
        for (int q = 0; q < 2; ++q) { const int row = row0 + q * NGW;
            const float* src = row < MREAL ? F.in[I_X] + (size_t)row * D : (row < MREAL + NMETA ? F.in[I_META] + (size_t)(row - MREAL) * D : nullptr);
#pragma unroll
            for (int j = 0; j < 8; ++j) v[q][j] = src ? __builtin_nontemporal_load((const f32x4*)(src + j * 256 + lane_ * 4)) : (f32x4){0.f, 0.f, 0.f, 0.f}; }
#pragma unroll
        for (int q = 0; q < 2; ++q) { const int row = row0 + q * NGW;
            if (row < MP) { float s = 0.f;
#pragma unroll
                for (int j = 0; j < 8; ++j) { const int c = j * 256 + lane_ * 4; const f32x4 x = v[q][j];
                    v2u w; w.x = pk2(x[0], x[1]); w.y = pk2(x[2], x[3]); *(v2u*)(HB + (size_t)row * D + c) = w;
                    s += (x[0] * x[0] + x[1] * x[1]) + (x[2] * x[2] + x[3] * x[3]); }
                s = wave_sum(s);
                if (lane_ == 0) ss0[row] = ss_fix(s); } }
    }
    bf16* O = (bf16*)(F.ws + WS_O);
    for (int i = gw * 64 + lane_; i < (MP - MREAL) * KBR / 8; i += NGW * 64) *(v4u*)(O + (size_t)MREAL * KBR + (size_t)i * 8) = (v4u){0u, 0u, 0u, 0u};
    bf16* QKVp = (bf16*)(F.ws + WS_QKV); bf16* VTp = (bf16*)(F.ws + WS_VT);
    for (int i = gw * 64 + lane_; i < 16 * NQKV / 8; i += NGW * 64) *(v4u*)(QKVp + (size_t)(MREAL + 16) * NQKV + (size_t)i * 8) = (v4u){0u, 0u, 0u, 0u};
    for (int i = gw * 64 + lane_; i < NVT * 2; i += NGW * 64) *(v4u*)(VTp + (size_t)(i >> 1) * MP + MREAL + 16 + 8 * (i & 1)) = (v4u){0u, 0u, 0u, 0u};
}
__device__ __forceinline__ void final_norm(Frame& F) {
    int lane_ = lane_id(), wave_ = F.wave; asm volatile("" : "+v"(lane_)); asm volatile("" : "+s"(wave_));
    const int gw = F.wg * NWAVES + wave_, NGW = F.G * NWAVES;
    const bf16* HB = (const bf16*)(F.ws + WS_HB); const ssq_t* ss = (const ssq_t*)(F.ws + WS_CTL + CTL_SS) + 6 * MP; const float* g = F.in[I_NFIN];
    f32x4 gv[8];
#pragma unroll
    for (int j = 0; j < 8; ++j) gv[j] = *(const f32x4*)(g + j * 256 + lane_ * 4);
    for (int row0 = gw; row0 < MREAL; row0 += 4 * NGW) {
        v2u o[4][8]; float rs[4];
#pragma unroll
        for (int q = 0; q < 4; ++q) { const int row = row0 + q * NGW; const int rr = row < MREAL ? row : row0;
            rs[q] = rstd_of(ss[rr]);
#pragma unroll
            for (int j = 0; j < 8; ++j) o[q][j] = __builtin_nontemporal_load((const v2u*)(HB + (size_t)rr * D + j * 256 + lane_ * 4)); }
#pragma unroll
        for (int q = 0; q < 4; ++q) { const int row = row0 + q * NGW;
            if (row < MREAL) {
#pragma unroll
                for (int j = 0; j < 8; ++j) { const v2u w = o[q][j];
                    f32x4 v; v[0] = __builtin_bit_cast(float, w.x << 16); v[1] = __builtin_bit_cast(float, w.x & 0xffff0000u); v[2] = __builtin_bit_cast(float, w.y << 16); v[3] = __builtin_bit_cast(float, w.y & 0xffff0000u);
                    __builtin_nontemporal_store(v * rs[q] * gv[j], (f32x4*)(F.out + (size_t)row * D + j * 256 + lane_ * 4)); } } }
    }
}
#define MFMA16(a, b, c) __builtin_amdgcn_mfma_f32_16x16x32_bf16((a), (b), (c), 0, 0, 0)
__device__ __forceinline__ f32x4 mini_dot(const bf16* A, int lda, const bf16* Bt, int ldb, int n0, int k0, int ksteps, int lane) {
    const int r = lane & 15, q = lane >> 4;
    const bf16* ap = A + (size_t)r * lda + k0 + 8 * q; const bf16* bp = Bt + (size_t)(n0 + r) * ldb + k0 + 8 * q;
    f32x4 acc = (f32x4){0.f, 0.f, 0.f, 0.f};
    int s = 0;
    for (; s + 8 <= ksteps; s += 8) {
        bf16x8 a[8], b[8];
#pragma unroll
        for (int i = 0; i < 8; ++i) { a[i] = *(const bf16x8*)(ap + 32 * (s + i)); b[i] = *(const bf16x8*)(bp + 32 * (s + i)); }
#pragma unroll
        for (int i = 0; i < 8; ++i) acc = MFMA16(a[i], b[i], acc);
    }
    for (; s + 2 <= ksteps; s += 2) { const bf16x8 a0 = *(const bf16x8*)(ap + 32 * s), b0 = *(const bf16x8*)(bp + 32 * s), a1 = *(const bf16x8*)(ap + 32 * s + 32), b1 = *(const bf16x8*)(bp + 32 * s + 32);
        acc = MFMA16(a0, b0, acc); acc = MFMA16(a1, b1, acc); }
    if (s < ksteps) { const bf16x8 a0 = *(const bf16x8*)(ap + 32 * s), b0 = *(const bf16x8*)(bp + 32 * s); acc = MFMA16(a0, b0, acc); }
    return acc;
}
template <int NACC, class Spec>
__device__ __forceinline__ void meta_gemm(Frame& F, const Spec& S, int ngroups) {
    int lane = lane_id(), wave = F.wave; asm volatile("" : "+v"(lane)); asm volatile("" : "+s"(wave));
    LAS float* part = (LAS float*)F.lds;
    constexpr int SLOTS = 4, SLOT_FLOATS = 8 * NACC * 256;
    for (int g0 = F.wg; g0 < ngroups; g0 += F.G * SLOTS) {
#pragma nounroll
        for (int sl = 0; sl < SLOTS; ++sl) { const int g = g0 + sl * F.G; if (g >= ngroups) break;
            f32x4 acc[NACC]; S.dot(g, wave, lane, acc);
#pragma unroll
            for (int a = 0; a < NACC; ++a)
#pragma unroll
                for (int j = 0; j < 4; ++j) part[sl * SLOT_FLOATS + ((wave * NACC + a) * 4 + j) * 64 + lane] = acc[a][j]; }
        __syncthreads();
        if (wave < SLOTS) { const int g = g0 + wave * F.G;
            if (g < ngroups) { f32x4 acc[NACC];
#pragma unroll
                for (int a = 0; a < NACC; ++a)
#pragma unroll
                    for (int j = 0; j < 4; ++j) { float s = 0.f;
#pragma unroll
                        for (int w = 0; w < 8; ++w) s += part[wave * SLOT_FLOATS + ((w * NACC + a) * 4 + j) * 64 + lane];
                        acc[a][j] = s; }
                S.epi(g, lane, acc); } }
        __syncthreads();
    }
}
template <int NACC, int KS, int SLOTS, class Spec>
__device__ __forceinline__ void meta_gemm2(Frame& F, const Spec& S, int ngroups, int vwg, int vG) {
    int lane = lane_id(), wave = F.wave; asm volatile("" : "+v"(lane)); asm volatile("" : "+s"(wave));
    LAS float* part = (LAS float*)F.lds;
    constexpr int SLOT_FLOATS = 8 * NACC * 256;
    const int r = lane & 15, q = lane >> 4, k0 = wave * KS * 32 + 8 * q;
    for (int g0 = (vwg < vG) ? vwg : ngroups; g0 < ngroups; g0 += vG * SLOTS) {
        bf16x8 a[KS], b[SLOTS][NACC][KS];
        { const bf16* ap = S.a_ptr() + (size_t)r * S.a_ld() + k0;
#pragma unroll
          for (int s = 0; s < KS; ++s) a[s] = *(const bf16x8*)(ap + 32 * s); }
#pragma unroll
        for (int sl = 0; sl < SLOTS; ++sl) { const int g = g0 + sl * vG;
            if (g < ngroups) {
#pragma unroll
                for (int c = 0; c < NACC; ++c) { const bf16* bp = S.w_ptr() + (size_t)(S.brow(g, c) + r) * S.w_ld() + k0;
#pragma unroll
                    for (int s = 0; s < KS; ++s) b[sl][c][s] = *(const bf16x8*)(bp + 32 * s); } } }
#pragma unroll
        for (int sl = 0; sl < SLOTS; ++sl) { const int g = g0 + sl * vG;
            if (g < ngroups) {
#pragma unroll
                for (int c = 0; c < NACC; ++c) { f32x4 acc = (f32x4){0.f, 0.f, 0.f, 0.f};
#pragma unroll
                    for (int s = 0; s < KS; ++s) acc = MFMA16(a[s], b[sl][c][s], acc);
#pragma unroll
                    for (int j = 0; j < 4; ++j) part[sl * SLOT_FLOATS + ((wave * NACC + c) * 4 + j) * 64 + lane] = acc[j]; } } }
        __syncthreads();
        if (wave < SLOTS) { const int g = g0 + wave * vG;
            if (g < ngroups) { f32x4 acc[NACC];
#pragma unroll
                for (int c = 0; c < NACC; ++c)
#pragma unroll
                    for (int j = 0; j < 4; ++j) { float sum = 0.f;
#pragma unroll
                        for (int w = 0; w < 8; ++w) sum += part[wave * SLOT_FLOATS + ((w * NACC + c) * 4 + j) * 64 + lane];
                        acc[c][j] = sum; }
                S.epi(g, lane, acc); } }
        __syncthreads();
    }
}
struct MetaGU { const bf16* A; const bf16* W; bf16* G; const ssq_t* ss;
    __device__ __forceinline__ const bf16* a_ptr() const { return A; } __device__ __forceinline__ int a_ld() const { return D; } __device__ __forceinline__ const bf16* w_ptr() const { return W; } __device__ __forceinline__ int w_ld() const { return D; }
    __device__ __forceinline__ int brow(int g, int c) const { const int c0 = 16 * g; return (c0 >> 7) * 256 + (c0 & 127) + 128 * c; }
    __device__ __forceinline__ void dot(int g, int wave, int lane, f32x4 (&acc)[2]) const { const int c0 = 16 * g, gr = (c0 >> 7) * 256 + (c0 & 127);
        acc[0] = mini_dot(A, D, W, D, gr, wave * (D / 8), D / 256, lane); acc[1] = mini_dot(A, D, W, D, gr + 128, wave * (D / 8), D / 256, lane); }
    __device__ __forceinline__ void epi(int g, int lane, const f32x4 (&acc)[2]) const { const int c = 16 * g + (lane & 15), q = lane >> 4;
#pragma unroll
        for (int j = 0; j < 4; ++j) { const int row = MREAL + 4 * q + j; const float rs = rstd_of(ss[row]); const float gv = acc[0][j] * rs, uv = acc[1][j] * rs;
            G[(size_t)row * FF + c] = (bf16)f2bf(gv * sigmoidf_(gv) * uv); } }
};
struct MetaResid { const bf16* A; int lda; const bf16* W; int K; bf16* HB; ssq_t* ssout; float alpha;
    __device__ __forceinline__ const bf16* a_ptr() const { return A; } __device__ __forceinline__ int a_ld() const { return lda; } __device__ __forceinline__ const bf16* w_ptr() const { return W; } __device__ __forceinline__ int w_ld() const { return K; }
    __device__ __forceinline__ int brow(int g, int) const { return 16 * g; }
    __device__ __forceinline__ void dot(int g, int wave, int lane, f32x4 (&acc)[1]) const { acc[0] = mini_dot(A, lda, W, K, 16 * g, wave * (K / 8), K / 256, lane); }
    __device__ __forceinline__ void epi(int g, int lane, const f32x4 (&acc)[1]) const { const int c = 16 * g + (lane & 15), q = lane >> 4;
#pragma unroll
        for (int j = 0; j < 4; ++j) { const int row = MREAL + 4 * q + j; const size_t off = (size_t)row * D + c; const float h = __builtin_bit_cast(float, (unsigned)HB[off] << 16) + alpha * acc[0][j];
            HB[off] = (bf16)f2bf(h); float p = h * h;
            p += __shfl_xor(p, 1); p += __shfl_xor(p, 2); p += __shfl_xor(p, 4); p += __shfl_xor(p, 8);
            if ((lane & 15) == 0) atomicAdd(ssout + row, ss_fix(p)); } }
};
struct MetaIn { const bf16* A; const bf16* W; bf16* QKV; unsigned char* GATES; const ssq_t* ss;
    __device__ __forceinline__ const bf16* a_ptr() const { return A; } __device__ __forceinline__ int a_ld() const { return D; } __device__ __forceinline__ const bf16* w_ptr() const { return W; } __device__ __forceinline__ int w_ld() const { return D; }
    __device__ __forceinline__ int brow(int g, int) const { return 16 * g; }
    __device__ __forceinline__ void dot(int g, int wave, int lane, f32x4 (&acc)[1]) const { acc[0] = mini_dot(A, D, W, D, 16 * g, wave * (D / 8), D / 256, lane); }
    __device__ __forceinline__ void epi(int g, int lane, const f32x4 (&acc)[1]) const { const int n = 16 * g + (lane & 15), q = lane >> 4;
#pragma unroll
        for (int j = 0; j < 4; ++j) { const int row = MREAL + 4 * q + j; const float v = acc[0][j] * rstd_of(ss[row]);
            if (n < NQKV) QKV[(size_t)row * NQKV + n] = (bf16)f2bf(v); else GATES[(size_t)row * NGATE + n - NQKV] = (unsigned char)gate_code(v); } }
};
struct MetaVT { const bf16* A; const bf16* W; bf16* VT; const ssq_t* ss;
    __device__ __forceinline__ const bf16* a_ptr() const { return A; } __device__ __forceinline__ int a_ld() const { return D; } __device__ __forceinline__ const bf16* w_ptr() const { return W; } __device__ __forceinline__ int w_ld() const { return D; }
    __device__ __forceinline__ int brow(int g, int) const { return 16 * g; }
    __device__ __forceinline__ void dot(int g, int wave, int lane, f32x4 (&acc)[1]) const { acc[0] = mini_dot(A, D, W, D, 16 * g, wave * (D / 8), D / 256, lane); }
    __device__ __forceinline__ void epi(int g, int lane, const f32x4 (&acc)[1]) const { const int n = 16 * g + (lane & 15), q = lane >> 4;
        v2u w; w.x = pk2(acc[0][0] * rstd_of(ss[MREAL + 4 * q]), acc[0][1] * rstd_of(ss[MREAL + 4 * q + 1])); w.y = pk2(acc[0][2] * rstd_of(ss[MREAL + 4 * q + 2]), acc[0][3] * rstd_of(ss[MREAL + 4 * q + 3]));
        *(v2u*)(VT + (size_t)n * MP + MREAL + 4 * q) = w; }
};
struct MetaBr { const bf16* O; const bf16* W; bf16* Y; const unsigned char* GATES;
    __device__ __forceinline__ void dot(int g, int wave, int lane, f32x4 (&acc)[3]) const {
#pragma unroll
        for (int b = 0; b < 3; ++b) acc[b] = mini_dot(O, KBR, W, KBR, 16 * g, 512 * b + wave * 64, 2, lane); }
    __device__ __forceinline__ void epi(int g, int lane, const f32x4 (&acc)[3]) const { const int c = 16 * g + (lane & 15), q = lane >> 4;
#pragma unroll
        for (int j = 0; j < 4; ++j) { const int row = MREAL + 4 * q + j; const unsigned char* gp = GATES + (size_t)row * NGATE + c;
            const float y = ((float)gp[0] * acc[0][j] + (float)gp[D] * acc[1][j] + (float)gp[2 * D] * acc[2][j]) * (1.f / 255.f);
            Y[(size_t)row * D + c] = (bf16)f2bf(y); } }
};
#define MFMA32(a, b, c) __builtin_amdgcn_mfma_f32_32x32x16_bf16((a), (b), (c), 0, 0, 0)
typedef float f32x2_t __attribute__((ext_vector_type(2))); typedef __bf16 bf16x2_t __attribute__((ext_vector_type(2)));
__device__ __forceinline__ unsigned cvtpk(float lo, float hi) { f32x2_t v = {lo, hi}; bf16x2_t b = __builtin_convertvector(v, bf16x2_t); return __builtin_bit_cast(unsigned, b); }
__device__ __forceinline__ int kappa(int r) { return (r & 0x13) | ((r & 4) << 1) | ((r & 8) >> 1); }
__device__ __forceinline__ int rel_bucket(int d) {
    if (d < 16) return d;
    return 16 + (d >= 19) + (d >= 21) + (d >= 24) + (d >= 27) + (d >= 31) + (d >= 35) + (d >= 40) + (d >= 46) + (d >= 52) + (d >= 59) + (d >= 67) + (d >= 77) + (d >= 87) + (d >= 99) + (d >= 113);
}
__device__ __forceinline__ void xhalf_swap(unsigned& a, unsigned& b) { asm volatile("v_nop\n\tv_nop\n\tv_permlane32_swap_b32 %0, %1" : "+v"(a), "+v"(b)); }
__device__ __forceinline__ float xhalf_max(float v) { unsigned a = __builtin_bit_cast(unsigned, v), b = a; xhalf_swap(a, b); return fmaxf(__builtin_bit_cast(float, a), __builtin_bit_cast(float, b)); }
__device__ __forceinline__ float xhalf_sum(float v) { unsigned a = __builtin_bit_cast(unsigned, v), b = a; xhalf_swap(a, b); return __builtin_bit_cast(float, a) + __builtin_bit_cast(float, b); }
constexpr float NEG_INF = -__builtin_huge_valf();
constexpr float M_INIT = -1e30f;

constexpr int AT_ROW = 144, AT_K_BYTES = 64 * AT_ROW, AT_V_BYTES = 128 * AT_ROW, AT_BUF = AT_K_BYTES + AT_V_BYTES;
constexpr int AT_TPB = 2;
static_assert(2 * AT_TPB * AT_BUF <= RING_BYTES, "attention tile buffers");
__device__ __forceinline__ int slot_row(int b, int s) { return s < 32 ? MREAL + s : b * T + s - 32; }
__device__ __forceinline__ float mask_sel(float v, unsigned w, int off) { const unsigned m = (unsigned)__builtin_amdgcn_sbfe((int)w, off, 1); float r;
    asm("v_bfi_b32 %0, %1, %2, %3" : "=v"(r) : "v"(m), "v"(v), "s"(0xff800000u)); return r; }
template <int DV> struct TileRegs { v4u k; v4u v[DV / 64]; };
template <int DV> __device__ __forceinline__ void tile_load(TileRegs<DV>& R, const bf16* __restrict__ QKV, const bf16* __restrict__ VT, int b, int kcol, int vrow, int st, int tid) {
    { const int row = tid >> 3, ch = tid & 7; R.k = *(const v4u*)(QKV + (size_t)slot_row(b, 64 * st + row) * NQKV + kcol + 8 * ch); }
#pragma unroll
    for (int i = 0; i < DV / 64; ++i) { const int p = tid + 512 * i, d = p >> 3, ch = p & 7; R.v[i] = *(const v4u*)(VT + (size_t)(vrow + d) * MP + slot_row(b, 64 * st + 8 * ch)); }
}
template <int DV> __device__ __forceinline__ void tile_store(const TileRegs<DV>& R, LAS unsigned char* buf, int tid) {
    { const int row = tid >> 3, ch = tid & 7; *(LAS v4u*)(buf + row * AT_ROW + 16 * ch) = R.k; }
#pragma unroll
    for (int i = 0; i < DV / 64; ++i) { const int p = tid + 512 * i, d = p >> 3, ch = p & 7; *(LAS v4u*)(buf + AT_K_BYTES + d * AT_ROW + 16 * ch) = R.v[i]; }
}
template <int ND, int MODE, int TPB>
__device__ __forceinline__ float flash_job(f32x16 (&O)[ND], const bf16* __restrict__ QKV, const bf16* __restrict__ VT, LAS unsigned char* lds, int b, int kcol, int vrow, int st_lo, int st_hi,
                                           bool active, int j, int qcol, const LAS float* lut, float m0, float l0, const LAS unsigned* mrow, int tid, int lane) {
    constexpr int DV = 32 * ND;
    const int r = lane & 31, h = lane >> 5, kap = kappa(r);
    const int qrow = (j >= 0) ? b * T + 32 * j + r : MREAL + r;
    const int qs = (j >= 0) ? 32 * (j + 1) + r : r;
    const int qp = qs < 32 ? qs : qs - 16;
    const int qs_hi = (j >= 0) ? 32 * (j + 1) + 31 : 31;
    bf16x8 qf[4];
#pragma unroll
    for (int d0 = 0; d0 < 4; ++d0) qf[d0] = *(const bf16x8*)(QKV + (size_t)qrow * NQKV + qcol + 16 * d0 + 8 * h);
    float m = m0, l = l0;
#pragma unroll
    for (int d = 0; d < ND; ++d)
#pragma unroll
        for (int i = 0; i < 16; ++i) O[d][i] = 0.f;
    const float c = 0.125f * LOG2E;
    const float lut_far = lut[128];
    constexpr int ABUF = AT_K_BYTES + DV * AT_ROW;
    static_assert(MODE == 0 ? TPB * ABUF <= RING_BYTES : 2 * TPB * ABUF <= RING_BYTES, "attention tile buffers");
    const int s1 = st_lo > 1 ? st_lo : 1;
#define FJ_TILE(sg_, tt_) ((MODE == 0) ? ((tt_) == 0 ? 0 : s1 + (tt_) - 1) : (sg_) + (tt_))
    TileRegs<DV> R[TPB];
    __syncthreads();
#pragma unroll
    for (int tt = 0; tt < TPB; ++tt) if (MODE != 0 || FJ_TILE(0, tt) <= st_hi) tile_load<DV>(R[tt], QKV, VT, b, kcol, vrow, FJ_TILE(0, tt), tid);
    int sg = 0, pb = 0;
    for (;;) {
        LAS unsigned char* gbuf = lds + pb * (TPB * ABUF);
#pragma unroll
        for (int tt = 0; tt < TPB; ++tt) if (MODE != 0 || FJ_TILE(sg, tt) <= st_hi) tile_store<DV>(R[tt], gbuf + tt * ABUF, tid);
        __syncthreads();
        const int nsg = (MODE == 0) ? st_hi + 1 : sg + TPB;
        if (nsg <= st_hi) {
#pragma unroll
            for (int tt = 0; tt < TPB; ++tt) tile_load<DV>(R[tt], QKV, VT, b, kcol, vrow, nsg + tt, tid); }
#pragma unroll
        for (int tt = 0; tt < TPB; ++tt) {
        const int st = FJ_TILE(sg, tt); LAS unsigned char* buf = gbuf + tt * ABUF;
        bool need = active && (64 * st <= qs_hi);
        if (MODE == 0 && st > 0) need = need && (64 * st + 63 >= 32 * (j + 1) - 127);
        if (need) {
            constexpr int NH = 2;
#pragma unroll
            for (int h0 = 0; h0 < 2; h0 += NH) {
                f32x16 sv[NH];
#pragma unroll
                for (int e = 0; e < NH; ++e)
#pragma unroll
                    for (int i = 0; i < 16; ++i) sv[e][i] = 0.f;
#pragma unroll
                for (int d0 = 0; d0 < 4; ++d0)
#pragma unroll
                    for (int e = 0; e < NH; ++e) { const bf16x8 kk = *(const LAS bf16x8*)(buf + (32 * (h0 + e) + kap) * AT_ROW + 32 * d0 + 16 * h); sv[e] = MFMA32(kk, qf[d0], sv[e]); }
                unsigned wm[NH];
#pragma unroll
                for (int e = 0; e < NH; ++e) wm[e] = (MODE == 2) ? mrow[2 * st + h0 + e] : 0u;
                const bool far = (MODE != 0) && (st >= 1) && (32 * j - 64 * st >= 159);
                float t[16 * NH];
                if (far) {
#pragma unroll
                    for (int e = 0; e < NH; ++e)
#pragma unroll
                        for (int i = 0; i < 16; ++i) { const int off = 16 * (i >> 3) + 8 * h + (i & 7); const float v = sv[e][i] * c + lut_far;
                            t[16 * e + i] = (MODE == 2) ? mask_sel(v, wm[e], off) : v; }
                } else {
                    float bl[16 * NH];
#pragma unroll
                    for (int e = 0; e < NH; ++e)
#pragma unroll
                        for (int i = 0; i < 16; ++i) { const int off = 16 * (i >> 3) + 8 * h + (i & 7); const int ks = 64 * st + 32 * (h0 + e) + off; const int kp = ks < 32 ? ks : ks - 16; const int dist = qp - kp;
                            const int idx = dist < 0 ? 0 : (dist > 128 ? 128 : dist); bl[16 * e + i] = lut[idx]; }
                    __builtin_amdgcn_sched_barrier(0);
#pragma unroll
                    for (int e = 0; e < NH; ++e)
#pragma unroll
                        for (int i = 0; i < 16; ++i) { const int off = 16 * (i >> 3) + 8 * h + (i & 7); const int ks = 64 * st + 32 * (h0 + e) + off; const int kp = ks < 32 ? ks : ks - 16; const int dist = qp - kp;
                            const float v = sv[e][i] * c + bl[16 * e + i];
                            if (MODE == 2) t[16 * e + i] = mask_sel(v, wm[e], off);
                            else { bool ok = (dist >= 0) && (ks < 16 || ks >= 32); if (MODE == 0) ok = ok && (ks < 32 || dist < 128); t[16 * e + i] = ok ? v : NEG_INF; } }
                }
                float tmax = t[0];
#pragma unroll
                for (int i = 1; i < 16 * NH; ++i) tmax = fmaxf(tmax, t[i]);

                if (__any(tmax > m + 8.f)) { const float mnew = fmaxf(m, xhalf_max(tmax)); const float alpha = fast_exp2(m - mnew); l *= alpha;
#pragma unroll
                    for (int d = 0; d < ND; ++d)
#pragma unroll
                        for (int i = 0; i < 16; ++i) O[d][i] *= alpha;
                    m = mnew; }
                float ps = 0.f;
#pragma unroll
                for (int i = 0; i < 16 * NH; ++i) { t[i] = fast_exp2(t[i] - m); ps += t[i]; }
                l += ps;
                bf16x8 pf[2 * NH];
#pragma unroll
                for (int g = 0; g < 2 * NH; ++g) { v4u pw; pw.x = cvtpk(t[8 * g], t[8 * g + 1]); pw.y = cvtpk(t[8 * g + 2], t[8 * g + 3]); pw.z = cvtpk(t[8 * g + 4], t[8 * g + 5]); pw.w = cvtpk(t[8 * g + 6], t[8 * g + 7]); pf[g] = __builtin_bit_cast(bf16x8, pw); }
#pragma unroll
                for (int d = 0; d < ND; ++d)
#pragma unroll
                    for (int g = 0; g < 2 * NH; ++g) { const bf16x8 vf = *(const LAS bf16x8*)(buf + AT_K_BYTES + (32 * d + r) * AT_ROW + 64 * h0 + 32 * g + 16 * h); O[d] = MFMA32(vf, pf[g], O[d]); }
            }
        }
        }
        if (nsg > st_hi) break;
        sg = nsg; pb ^= 1;
    }
#undef FJ_TILE
    return xhalf_sum(l);
}
template <int ND>
__device__ __forceinline__ void store_o(bf16* Obuf, int qrow, int col0, const f32x16 (&O)[ND], float scale, bool valid, int lane) {
    const int h = lane >> 5;
    if (!valid) return;
#pragma unroll
    for (int d = 0; d < ND; ++d)
#pragma unroll
        for (int g = 0; g < 4; ++g) { v2u w; w.x = cvtpk(O[d][4 * g] * scale, O[d][4 * g + 1] * scale); w.y = cvtpk(O[d][4 * g + 2] * scale, O[d][4 * g + 3] * scale);
            *(v2u*)(Obuf + (size_t)qrow * KBR + col0 + 32 * d + 8 * g + 4 * h) = w; }
}
struct AttnCtx { const bf16* QKV; const bf16* VT; bf16* O; const LAS float* lut; const float* sinks; const float* subln; float lam, lam_init; LAS unsigned char* lds; };

__device__ __forceinline__ void job_a(const AttnCtx& C, int b, int kvh, int jp, int tid, int wave, int lane) {
    asm volatile("" : "+v"(lane)); asm volatile("" : "+v"(tid));
    f32x16 O[2]; const int r = lane & 31, h = lane >> 5, hq = kvh * 4 + (wave & 3);
    const int j = jp >= 0 ? 2 * jp + (wave >> 2) : -1; const bool active = jp >= 0 || wave < 4;
    const int st_lo = jp >= 0 ? jp - 2 : 1, st_hi = jp >= 0 ? jp + 1 : 0;
    const float l = flash_job<2, 0, 5>(O, C.QKV, C.VT, C.lds, b, C_AK + kvh * 64, R_AV + kvh * 64, st_lo, st_hi, active, j, C_AQ + hq * 64, C.lut + hq * LUT_STRIDE, C.sinks[hq] * LOG2E, h == 0 ? 1.f : 0.f, nullptr, tid, lane);
    const int qrow = (j >= 0) ? b * T + 32 * j + r : MREAL + r;
    store_o<2>(C.O, qrow, hq * 64, O, 1.f / l, active && (j >= 0 || r < NMETA), lane);
}
__device__ __forceinline__ void job_c(const AttnCtx& C, int b, int j, const LAS unsigned* mask, int tid, int wave, int lane) {
    asm volatile("" : "+v"(lane)); asm volatile("" : "+v"(tid));
    f32x16 O[2]; const int r = lane & 31; const int st_hi = j >= 0 ? (j + 1) >> 1 : 0;
    float l;
    if (j >= 0) l = flash_job<2, 2, 3>(O, C.QKV, C.VT, C.lds, b, C_CK, R_CV, 1, st_hi, true, j, C_CQ + wave * 64, C.lut + (12 + wave) * LUT_STRIDE, M_INIT, 0.f, mask + r * MASK_STRIDE, tid, lane);
    else        l = flash_job<2, 1, 3>(O, C.QKV, C.VT, C.lds, b, C_CK, R_CV, 1, st_hi, true, j, C_CQ + wave * 64, C.lut + (12 + wave) * LUT_STRIDE, M_INIT, 0.f, nullptr, tid, lane);
    const int qrow = (j >= 0) ? b * T + 32 * j + r : MREAL + r;
    store_o<2>(C.O, qrow, 1024 + wave * 64, O, 1.f / l, j >= 0 || r < NMETA, lane);
}
__device__ __forceinline__ void job_b(const AttnCtx& C, int b, int hd, int g, float* stash  , int tid, int wave, int lane) {
    const LAS float* lut = C.lut + (8 + hd) * LUT_STRIDE;
    const int j = g >= 0 ? 8 * g + wave : -1; const bool active = g >= 0 || wave == 0; const int st_hi = g >= 0 ? 4 * g + 4 : 0;
#pragma nounroll
    for (int map = 0; map < 2; ++map) {
        asm volatile("" : "+v"(lane)); asm volatile("" : "+v"(tid));
        f32x16 O[4]; const int r = lane & 31, h = lane >> 5;
        const float l = flash_job<4, 1, AT_TPB>(O, C.QKV, C.VT, C.lds, b, (map ? C_BK2 : C_BK1) + hd * 64, R_BV + hd * 128, 1, st_hi, active, j, (map ? C_BQ2 : C_BQ1) + hd * 64, lut, M_INIT, 0.f, nullptr, tid, lane);
        if (!active) continue;
        if (map == 0) { const float inv = 1.f / l;
#pragma unroll
            for (int d = 0; d < 4; ++d)
#pragma unroll
                for (int g4 = 0; g4 < 4; ++g4) *(f32x4*)(stash + lane * 64 + d * 16 + g4 * 4) = (f32x4){O[d][4 * g4] * inv, O[d][4 * g4 + 1] * inv, O[d][4 * g4 + 2] * inv, O[d][4 * g4 + 3] * inv};
        } else {
            const float inv = C.lam / l; float ssq = 0.f;
#pragma unroll
            for (int d = 0; d < 4; ++d)
#pragma unroll
                for (int g4 = 0; g4 < 4; ++g4) { const f32x4 sv4 = *(const f32x4*)(stash + lane * 64 + d * 16 + g4 * 4);
#pragma unroll
                    for (int k = 0; k < 4; ++k) { const float o = sv4[k] - O[d][4 * g4 + k] * inv; O[d][4 * g4 + k] = o; ssq += o * o; } }
            ssq = xhalf_sum(ssq);
            const float rs = rsqrtf(ssq * (1.0f / 128.f) + EPS) * (1.f - C.lam_init);
#pragma unroll
            for (int d = 0; d < 4; ++d)
#pragma unroll
                for (int gg = 0; gg < 4; ++gg) { const f32x4 gv = *(const f32x4*)(C.subln + 32 * d + 8 * gg + 4 * h);
#pragma unroll
                    for (int k = 0; k < 4; ++k) O[d][4 * gg + k] *= gv[k]; }
            const int qrow = (j >= 0) ? b * T + 32 * j + r : MREAL + r;
            store_o<4>(C.O, qrow, 512 + hd * 128, O, rs, j >= 0 || r < NMETA, lane);
        }
    }
}
constexpr int AT_QI_OFF = 0, AT_QI_ROW = 1040;
static_assert(AT_QI_OFF + 32 * AT_QI_ROW <= RING_BYTES, "indexer Q stage");
__device__ __forceinline__ void idx_scores(const AttnCtx& C, int b, int j, float* Sws, int tid, int wave, int lane) {
    asm volatile("" : "+v"(lane)); asm volatile("" : "+v"(tid));
    const int r = lane & 31, h = lane >> 5, kap = kappa(r);
    const int qrow0 = b * T + 32 * j;
    LAS unsigned char* qs = C.lds + AT_QI_OFF;
    __syncthreads();
#pragma unroll
    for (int i = 0; i < 4; ++i) { const int p = tid + 512 * i, row = p >> 6, ch = p & 63;
        *(LAS v4u*)(qs + row * AT_QI_ROW + 16 * ch) = *(const v4u*)(C.QKV + (size_t)(qrow0 + row) * NQKV + C_IQ + 8 * ch); }
    float wq[8];
#pragma unroll
    for (int hd = 0; hd < 8; ++hd) wq[hd] = __builtin_bit_cast(float, (unsigned)C.VT[(size_t)(R_IW + hd) * MP + qrow0 + r] << 16) * (0.125f * 0.35355339059327373f);
    float* Srow = Sws + (size_t)r * SROW;
    bf16x8 kn[4];
    if (wave <= j + 1) { const int krow0 = (wave == 0) ? MREAL : b * T + 32 * (wave - 1);
#pragma unroll
        for (int d0 = 0; d0 < 4; ++d0) kn[d0] = *(const bf16x8*)(C.QKV + (size_t)(krow0 + kap) * NQKV + C_IK + 16 * d0 + 8 * h); }
    __syncthreads();
    float sp[16]; int ktp = -1;
#define IDX_STORE_PREV() do { if (ktp >= 0) { _Pragma("unroll") for (int q4 = 0; q4 < 4; ++q4) \
        *(f32x4*)(Srow + 32 * ktp + 16 * (q4 >> 1) + 8 * h + 4 * (q4 & 1)) = (f32x4){sp[4 * q4], sp[4 * q4 + 1], sp[4 * q4 + 2], sp[4 * q4 + 3]}; } } while (0)
    for (int kt = wave; kt <= j + 1; kt += 8) {
        bf16x8 kf[4];
#pragma unroll
        for (int d0 = 0; d0 < 4; ++d0) kf[d0] = kn[d0];
        IDX_STORE_PREV();
        if (kt + 8 <= j + 1) { const int krow1 = b * T + 32 * (kt + 7);
#pragma unroll
            for (int d0 = 0; d0 < 4; ++d0) kn[d0] = *(const bf16x8*)(C.QKV + (size_t)(krow1 + kap) * NQKV + C_IK + 16 * d0 + 8 * h); }
        float sc[16];
#pragma unroll
        for (int i = 0; i < 16; ++i) sc[i] = 0.f;
#pragma unroll
        for (int hd = 0; hd < 8; ++hd) { f32x16 a;
#pragma unroll
            for (int i = 0; i < 16; ++i) a[i] = 0.f;
#pragma unroll
            for (int d0 = 0; d0 < 4; ++d0) { const bf16x8 qf = *(const LAS bf16x8*)(qs + r * AT_QI_ROW + hd * 128 + 32 * d0 + 16 * h); a = MFMA32(kf[d0], qf, a); }
#pragma unroll
            for (int i = 0; i < 16; ++i) sc[i] += fmaxf(a[i], 0.f) * wq[hd];
            if (hd & 1) __builtin_amdgcn_sched_barrier(0); }
#pragma unroll
        for (int i = 0; i < 16; ++i) { const int koff = (i & 7) + 8 * h + 16 * (i >> 3);
            const bool ok = (kt == 0) ? (koff < 16) : (kt == j + 1 ? koff <= r : true);
            float v = sc[i]; if ((__builtin_bit_cast(unsigned, v) & 0x7fffffffu) == 0u) v = 0.f;
            sc[i] = ok ? v : NEG_INF; }
#pragma unroll
        for (int i = 0; i < 16; ++i) sp[i] = sc[i];
        ktp = kt;
    }
    IDX_STORE_PREV();
#undef IDX_STORE_PREV
}
__device__ __forceinline__ int wave_total6(int c) {
    c += __builtin_amdgcn_update_dpp(0, c, 0xB1, 0xf, 0xf, false);
    c += __builtin_amdgcn_update_dpp(0, c, 0x4E, 0xf, 0xf, false);
    c += __builtin_amdgcn_update_dpp(0, c, 0x141, 0xf, 0xf, false);
    c += __builtin_amdgcn_update_dpp(0, c, 0x140, 0xf, 0xf, false);
    return __builtin_amdgcn_readlane(c, 0) + __builtin_amdgcn_readlane(c, 16) + __builtin_amdgcn_readlane(c, 32) + __builtin_amdgcn_readlane(c, 48);
}
typedef unsigned short u16x2 __attribute__((ext_vector_type(2)));
__device__ __forceinline__ u16x2 pk_count_ge(u16x2 acc, u16x2 x, u16x2 cm1) {
    unsigned t, a = __builtin_bit_cast(unsigned, acc); const unsigned one = 0x00010001u;
    asm("v_pk_sub_u16 %0, %2, %3 clamp\n\tv_pk_min_u16 %0, %0, %4\n\tv_pk_add_u16 %1, %5, %0" : "=&v"(t), "=v"(a) : "v"(__builtin_bit_cast(unsigned, x)), "v"(__builtin_bit_cast(unsigned, cm1)), "s"(one), "1"(a));
    return __builtin_bit_cast(u16x2, a); }
__device__ __forceinline__ void idx_load(const float* Srow, int nslots, int lane, float (&lv)[34]) {
#pragma unroll
    for (int i = 0; i < 34; ++i) { const int slot = 64 * i + lane; lv[i] = Srow[slot < nslots ? slot : nslots - 1]; }
}
__device__ __forceinline__ void idx_select(float (&lv)[34], const float* next_row  , int nslots, int n_adm, LAS unsigned* mrow, LAS unsigned* wl  , int lane) {
    asm volatile("" : "+v"(lane));
    constexpr int NI = 34, NP = 20, NG = NP / 4;
    unsigned u[NI];
    const int ni = (nslots + 63) >> 6, ng = (((ni + 1) >> 1) + 3) >> 2;
#pragma unroll
    for (int i = 0; i < NI; ++i) { const int slot = 64 * i + lane; const float v = (slot < nslots) ? lv[i] : NEG_INF;
        const unsigned bits = __builtin_bit_cast(unsigned, v); u[i] = bits ^ ((bits >> 31) ? 0xffffffffu : 0x80000000u); }
    if (next_row) idx_load(next_row, nslots, lane, lv);
    const unsigned UNEG = 0x007fffffu;
    unsigned Tk = UNEG + 1u; int need = 1 << 30, nties = 0;
    const bool big = n_adm > 256;
    if (big) {
        u16x2 ph[NP];
#pragma unroll
        for (int p = 0; p < NP; ++p) ph[p] = (2 * p + 1 < NI) ? (u16x2){(unsigned short)(u[2 * p] >> 16), (unsigned short)(u[2 * p + 1] >> 16)} : (u16x2){0, 0};
        unsigned T1 = 0u;
        for (int bit = 15; bit >= 0; --bit) { const unsigned cand = T1 | (1u << bit); const unsigned short c1 = (unsigned short)(cand - 1u); const u16x2 cm1 = (u16x2){c1, c1}; u16x2 acc = (u16x2){0, 0};
#pragma unroll
            for (int gq = 0; gq < NG; ++gq) if (gq < ng) {
#pragma unroll
                for (int k = 0; k < 4; ++k) acc = pk_count_ge(acc, ph[4 * gq + k], cm1); }
            if (wave_total6((int)acc.x + (int)acc.y) >= 256) T1 = cand; }
        int cgl = 0;
#pragma unroll
        for (int i = 0; i < 33; ++i) if (i < ni) cgl += ((u[i] >> 16) > T1) ? 1 : 0;
        const int need2 = 256 - wave_total6(cgl);
        int M = 0; const unsigned long long ltm = (1ull << lane) - 1ull;
#pragma unroll
        for (int i = 0; i < 33; ++i) if (i < ni) { const bool inb = (u[i] >> 16) == T1; const unsigned long long mb = __ballot(inb);
            if (mb != 0ull) { const int pos = M + __builtin_popcountll(mb & ltm); if (inb && pos < 64) wl[pos] = u[i] & 0xffffu; M += __builtin_popcountll(mb); } }
        unsigned T2 = 0u;
        if (M <= 64) {
            const unsigned val = (lane < M) ? wl[lane] : 0u;
            for (int bit = 15; bit >= 0; --bit) { const unsigned cand = T2 | (1u << bit); if (__builtin_popcountll(__ballot(val >= cand)) >= need2) T2 = cand; }
        } else {
            u16x2 pl[NP];
    #pragma unroll
            for (int p = 0; p < NP; ++p) { unsigned short a0 = 0, a1 = 0; if (2 * p + 1 < NI) { a0 = ((u[2 * p] >> 16) == T1) ? (unsigned short)u[2 * p] : (unsigned short)0; a1 = ((u[2 * p + 1] >> 16) == T1) ? (unsigned short)u[2 * p + 1] : (unsigned short)0; } pl[p] = (u16x2){a0, a1}; }
            for (int bit = 15; bit >= 0; --bit) { const unsigned cand = T2 | (1u << bit); const unsigned short c1 = (unsigned short)(cand - 1u); const u16x2 cm1 = (u16x2){c1, c1}; u16x2 acc = (u16x2){0, 0};
    #pragma unroll
                for (int gq = 0; gq < NG; ++gq) if (gq < ng) {
    #pragma unroll
                    for (int k = 0; k < 4; ++k) acc = pk_count_ge(acc, pl[4 * gq + k], cm1); }
                if (wave_total6((int)acc.x + (int)acc.y) >= need2) T2 = cand; }
        }
        Tk = (T1 << 16) | T2;
        int cg = 0;
#pragma unroll
        for (int i = 0; i < 33; ++i) if (i < ni) cg += ((u[i] > Tk) ? 1 : 0) + ((u[i] == Tk) ? 65536 : 0);
        const int tot = wave_total6(cg);
        need = 256 - (tot & 0xffff); nties = tot >> 16;
    }
    if (!big || nties == need) {
        const unsigned Tsel = big ? Tk : UNEG + 1u;
#pragma unroll
        for (int i = 0; i < 33; ++i) if (i < ni) { const unsigned long long sb = __ballot(u[i] >= Tsel);
            if (lane == 0) { mrow[2 * i] = (unsigned)sb; mrow[2 * i + 1] = (unsigned)(sb >> 32); } }
        return;
    }
    int ties_before = 0; const unsigned long long lt = (1ull << lane) - 1ull;
#pragma unroll
    for (int i = 0; i < 33; ++i) if (i < ni) {
        const bool tie = (u[i] == Tk) && big; const unsigned long long tb = __ballot(tie);
        const int rank = ties_before + __builtin_popcountll(tb & lt); ties_before += __builtin_popcountll(tb);
        const bool sel = big ? ((u[i] > Tk) || (tie && rank < need)) : (u[i] > UNEG);
        const unsigned long long sb = __ballot(sel);
        if (lane == 0) { mrow[2 * i] = (unsigned)sb; mrow[2 * i + 1] = (unsigned)(sb >> 32); } }
}

#ifndef REP_B
#define REP_B 1
#endif
#ifndef REP_C1
#define REP_C1 1
#endif
#ifndef REP_C2
#define REP_C2 1
#endif
#ifndef REP_C3
#define REP_C3 1
#endif
constexpr int Q_BC = 768, Q_A = 512, Q_META = 1, Q_ITEMS = Q_BC + Q_A + Q_META;
__device__ __forceinline__ void attention_item(Frame& F, const AttnCtx& C, int q, int tid, int wave, int lane) {
    LAS unsigned* mask = (LAS unsigned*)(F.lds + LDS_MASK);
    float* Sws = (float*)(F.ws + WS_H) + (size_t)F.wg * 32 * SROW;
    if (q < Q_BC) { const int G8 = 7 - q / 96, rem = q % 96;
        if (rem < 32) {
#ifndef NO_B
            for (int rp = 0; rp < REP_B; ++rp) job_b(C, rem >> 2, rem & 3, G8, Sws + wave * 4096, tid, wave, lane);
#endif
        } else {
#ifndef NO_C
            const int cc = rem - 32, j = 8 * G8 + 7 - (cc >> 3), b = cc & 7;
            for (int rp = 0; rp < REP_C1; ++rp) idx_scores(C, b, j, Sws, tid, wave, lane);
            VM_WAIT(); __syncthreads();
            for (int rp = 0; rp < REP_C2; ++rp)
            { float lv[34]; const int ns = 32 * (j + 2); LAS unsigned* wl = (LAS unsigned*)(C.lds + wave * 256);
              idx_load(Sws + (size_t)(wave * 4) * SROW, ns, lane, lv);
#pragma nounroll
              for (int qq = 0; qq < 4; ++qq) { const int qi = wave * 4 + qq;
                  idx_select(lv, qq < 3 ? Sws + (size_t)(qi + 1) * SROW : (const float*)nullptr, ns, 16 + 32 * j + qi + 1, mask + qi * MASK_STRIDE, wl, lane); } }
            __syncthreads();
            for (int rp = 0; rp < REP_C3; ++rp) job_c(C, b, j, mask, tid, wave, lane);
#endif
        }
    } else if (q < Q_BC + Q_A) {
#ifndef NO_A
        const int ua = q - Q_BC; job_a(C, ua >> 6, (ua >> 5) & 1, ua & 31, tid, wave, lane);
#endif
    } else {
#ifndef NO_META
        job_a(C, 0, 0, -1, tid, wave, lane); job_a(C, 0, 1, -1, tid, wave, lane);
        job_c(C, 0, -1, mask, tid, wave, lane);
#pragma nounroll
        for (int hd = 0; hd < 4; ++hd) job_b(C, 0, hd, -1, Sws + wave * 4096, tid, wave, lane);
#endif
    }
}
__device__ __forceinline__ void attention_phase(Frame& F, int l, int rep = 0) {
    int lane_ = lane_id(), wave_ = F.wave; asm volatile("" : "+v"(lane_)); asm volatile("" : "+s"(wave_));
    const int tid_ = wave_ * 64 + lane_;
    LAS float* lut = (LAS float*)(F.lds + LDS_LUT);
    const float* table = F.in[I_TABLE];
    for (int i = tid_; i < 20 * 129; i += NWAVES * 64) { const int hd = i / 129, d = i - hd * 129; lut[hd * LUT_STRIDE + d] = table[rel_bucket(d) * 20 + hd] * LOG2E; }
    AttnCtx C; C.QKV = (const bf16*)(F.ws + WS_QKV); C.VT = (const bf16*)(F.ws + WS_VT); C.O = (bf16*)(F.ws + WS_O); C.lut = lut; C.lds = F.lds;
    C.sinks = F.in[I_SINK] + l * 8; C.subln = F.in[I_SUBLN] + l * 128;
    { const float* dl = F.in[I_DLAM] + l * 256; const float s1 = wave_sum(dl[lane_] * dl[64 + lane_]), s2 = wave_sum(dl[128 + lane_] * dl[192 + lane_]);
      C.lam_init = (l == 0) ? 0.2f : 0.35550907f; C.lam = expf(s1) - expf(s2) + C.lam_init; }
    volatile LAS unsigned* MISC = (volatile LAS unsigned*)(F.lds + LDS_MISC);
    unsigned* qctr = (unsigned*)(F.ws + WS_CTL) + 64 * (1 + l + 2 * rep);
    const int ncj = (l == 0) ? cv::JOBS_SET1 + cv::JOBS_SET0 : cv::JOBS_SET1;
    __syncthreads();
    for (;;) {
        if (tid_ == 0) MISC[16] = __hip_atomic_fetch_add(qctr, 1u, __ATOMIC_RELAXED, __HIP_MEMORY_SCOPE_AGENT);
        __syncthreads();
        const int q = (int)MISC[16];
        __syncthreads();
        if (q >= Q_ITEMS + ncj) break;
        const int grp = q >> 2, r = q & 3;
        if (r == 1 && grp < ncj) { if (grp < cv::JOBS_SET1) convert_job(F, l, 1, grp); else convert_job(F, 1, 0, grp - cv::JOBS_SET1); }
        else { const int before = grp + (r > 1), aq = q - (before < ncj ? before : ncj);
               if (aq > 0 || l == 0) attention_item(F, C, aq == 0 ? Q_ITEMS - 1 : aq - 1, tid_, wave_, lane_); }
    }
    __syncthreads();
}
template <class Sched>
__device__ __forceinline__ LAS const float* rstd_cache_fill(Frame& F, const ssq_t* ss, const Sched& S) {
    LAS float* rc = (LAS float*)(F.lds + LDS_RSC);
    pg8::Unit u0, u1, t; const bool any = S.next(0, u0); u1 = u0;
    if (any) { for (int i = 1; S.next(i, t); ++i) u1 = t; }
    const int pm0 = any ? u0.pm : -1, pm1 = (any && u1.pm != u0.pm) ? u1.pm : -1;
    int tid = F.wave * 64 + lane_id(); asm volatile("" : "+v"(tid));
    const int r = tid & 255, pm = (tid >> 8) ? pm1 : pm0;
    if (pm >= 0) rc[(tid >> 8) * 256 + r] = rstd_of(ss[pm * 256 + r]);
    if (tid == 0) { ((LAS int*)rc)[512] = pm0; ((LAS int*)rc)[513] = pm1; }
    __syncthreads();
    return rc;
}
constexpr int N_PHASES = 20;
struct GateOrder { int G, c;
    __device__ __forceinline__ bool next(int i, pg8::Unit& u) const { int t;
        if (G == 256) { const int cnt = c < 128 ? 5 : 7; if (i >= cnt) return false; t = (c < 128 ? 5 * c : 640 + 7 * (c - 128)) + i; }
        else { t = i * G + c; if (t >= 64 * 24) return false; }
        u.pm = t / 24; u.pn = t - u.pm * 24; u.seg = 0; return true; } };
struct SameTileOrder { int n; __device__ __forceinline__ bool next(int i, pg8::Unit& u) const { u.pm = 0; u.pn = 0; u.seg = 0; return i < n; } };
#ifndef REP_OUT
#define REP_OUT 1
#endif
#ifndef REP_INIT
#define REP_INIT 1
#endif
#ifndef REP_FIN
#define REP_FIN 1
#endif
#ifndef REP_META
#define REP_META 1
#endif
#ifndef REP_DN
#define REP_DN 1
#endif
#ifndef REP_BR
#define REP_BR 1
#endif
#ifndef REP_CONV
#define REP_CONV 1
#endif
#ifndef REP_ATT
#define REP_ATT 1
#endif
#ifndef REP_GU
#define REP_GU 1
#endif
#ifndef REP_IN
#define REP_IN 1
#endif
#ifndef ONLY_SITE
#define SITE_ON(k) 1
#else
#define SITE_ON(k) (ONLY_SITE == (k))
#endif
struct Args { const float* in[19]; float* out; unsigned char* ws; int ph_lo, ph_hi; };
__global__ void __launch_bounds__(NWAVES * 64, 2) fwd(Args args) {
    extern __shared__ __attribute__((aligned(16))) unsigned char lds[];
    Frame F;
    F.lds = (LAS unsigned char*)lds;
    F.wave = __builtin_amdgcn_readfirstlane((int)threadIdx.x >> 6);
    F.G = gridDim.x; F.wg = blockIdx.x; F.ws = args.ws; F.out = args.out;
#pragma unroll
    for (int i = 0; i < 19; ++i) F.in[i] = args.in[i];
    volatile LAS unsigned* MISC = (volatile LAS unsigned*)(F.lds + LDS_MISC);
    if (F.wave == 0) MISC[lane_id()] = 0u;
    __syncthreads();
    const int lo = args.ph_lo, hi = args.ph_hi;
    gu32* ctl = (gu32*)(F.ws + WS_CTL);
    XcdBarrier bar; bar.bar = (unsigned*)(ctl + CW_BAR); bar.x = 0; bar.st = nullptr; bar.wv = F.wave;
    if (hi - lo > 1) bar = xcd_barrier_post((unsigned*)(ctl + CW_BAR), MISC + 8, F.wave);
#define IN(k) (lo <= (k) && (k) < hi)
#ifndef REP_BAR
#define REP_BAR 1
#endif
#define SEAM(k) do { if (IN(k) && IN((k) + 1)) { for (int rb_ = 0; rb_ < REP_BAR; ++rb_) xcd_barrier(bar); } } while (0)
    unsigned char* const ws0 = F.ws;

    #ifndef NO_CONV
    if (IN(0)) {
#ifndef NO_INIT
        for (int rep = 0; rep < REP_INIT; ++rep) init_h(F);
#endif
#ifndef NO_CONV0
        for (int rep = 0; rep < REP_CONV; ++rep) convert_layer(F, 0, 0);
#endif
    }
#endif
    SEAM(0);
    for (int s = 0; s < 4; ++s) {
        const int l = s >> 1, f = s & 1, base = 1 + 9 * l;
        const int pg = base + 6 * f;
        unsigned char* ws = ws0; asm volatile("" : "+s"(ws));
        F.ws = ws;
        bf16* HB = (bf16*)(ws + WS_HB); bf16* GG = (bf16*)(ws + WS_GG); bf16* QKV = (bf16*)(ws + WS_QKV); bf16* Y = (bf16*)(ws + WS_QKV);
        bf16* VT = (bf16*)(ws + WS_VT); bf16* O = (bf16*)(ws + WS_O); ssq_t* SS = (ssq_t*)(ws + WS_CTL + CTL_SS);
#if SITE_ON(1)
        if (IN(pg)) for (int rep = 0; rep < REP_GU; ++rep) {
            pg8::Gemm g{HB, (const bf16*)(ws + (f ? WS_WGU2 : WS_WGU1)), D, D, D}; pg8::StaticOrder<1> S; S.init(MREAL, NGU, F.G, F.wg);
            EpiSwiGLU E{GG, (s >= FP8_DN_FROM) ? (unsigned char*)QKV : (unsigned char*)nullptr, SS + (size_t)(3 * l + 2 * f) * MP, rstd_cache_fill(F, SS + (size_t)(3 * l + 2 * f) * MP, S)};
            { MetaGU Mg{HB + (size_t)MREAL * D, g.Bt, GG, E.ss}; for (int rm = 0; rm < REP_META; ++rm) meta_gemm2<2, D / 256, 2, MetaGU>(F, Mg, (s < 3) ? FF / 16 : 0, F.wg, F.G); }
#ifdef PROBE_GU_NULL
            if (rep == 0) { EpiNull En{GG};
#if PROBE_GU_NULL == 2
                SameTileOrder S2{11};  pg8::gemm_phase<EpiNull, SameTileOrder, true>(F.lds, g, S2, En);
#else
                pg8::gemm_phase<EpiNull, pg8::StaticOrder<1>, true>(F.lds, g, S, En, F.wave);
#endif
            } else
#endif
            pg8::gemm_phase<EpiSwiGLU, pg8::StaticOrder<1>, true>(F.lds, g, S, E, F.wave);
        }
#endif
        SEAM(pg);
#if SITE_ON(2)
        if (IN(pg + 1)) for (int rep = 0; rep < REP_DN; ++rep) {
            const bool dn8 = (s >= FP8_DN_FROM);
            const bf16* Wd = (const bf16*)(ws + (f ? WS_WD2 : WS_WD1));
            pg8::StaticOrder<1> S; S.init(MREAL, D, F.G, F.wg);
            ssq_t* sso = (rep < REP_DN - 1) ? SS + (size_t)7 * MP : SS + (size_t)(3 * l + 1 + 2 * f) * MP; const float al = (rep < REP_DN - 1) ? 0.f : 0.5f;
            if (s < 3) { MetaResid Mr{GG + (size_t)MREAL * FF, FF, Wd, FF, HB, sso, al};     meta_gemm2<1, FF / 256, 1, MetaResid>(F, Mr, D / 16, F.wg, F.G); }
            if (dn8) { pg8::Gemm g{QKV, (const bf16*)(ws + (f ? WS_WD82 : WS_WD81)), FF / 2, FF / 2, FF / 2}; EpiResidF8 E{HB, sso, al / (G8_SCALE * WG8_SCALE)};
                pg8::gemm_phase<EpiResidF8, pg8::StaticOrder<1>, true>(F.lds, g, S, E, F.wave); }
            else { pg8::Gemm g{GG, Wd, FF, FF, FF}; EpiResid E{HB, sso, al};
                pg8::gemm_phase<EpiResid, pg8::StaticOrder<1>, true>(F.lds, g, S, E, F.wave); }
        }
#endif
        SEAM(pg + 1);
        if (f == 0) {
            if (IN(base + 2)) for (int rep = 0; rep < REP_IN; ++rep) {
#if SITE_ON(3)
                { const int mG = (F.G == 256) ? 128 : F.G;
                  MetaIn Mi{HB + (size_t)MREAL * D, (const bf16*)(ws + WS_WIN), QKV, (unsigned char*)GG, SS + (size_t)(3 * l + 1) * MP}; meta_gemm2<1, D / 256, 3, MetaIn>(F, Mi, NIN / 16, F.wg, mG);
                  MetaVT Mv{HB + (size_t)MREAL * D, (const bf16*)(ws + WS_WVT), VT, SS + (size_t)(3 * l + 1) * MP}; meta_gemm2<1, D / 256, 1, MetaVT>(F, Mv, NVT / 16, F.wg, mG); }
#ifndef TEST_NO_QKV
                { pg8::Gemm g{HB, (const bf16*)(ws + WS_WIN), D, D, D}; pg8::StaticOrder<1> S; S.init(MREAL, NQKV, F.G, F.wg);
                  EpiIn E{QKV, GG, SS + (size_t)(3 * l + 1) * MP, rstd_cache_fill(F, SS + (size_t)(3 * l + 1) * MP, S)};
                  pg8::gemm_phase<EpiIn, pg8::StaticOrder<1>, true>(F.lds, g, S, E, F.wave); }
#endif
#ifndef TEST_NO_G8
                { pg8::Gemm g{(const bf16*)(ws + WS_HB8), (const bf16*)(ws + WS_WG8), D / 2, D / 2, D / 2, 256};
                  GateOrder S{F.G, F.wg};
                  EpiGates8 E{(unsigned char*)GG, SS + (size_t)(3 * l + 1) * MP, rstd_cache_fill(F, SS + (size_t)(3 * l + 1) * MP, S)};
                  pg8::gemm_phase<EpiGates8, GateOrder, true>(F.lds, g, S, E, F.wave); }
#endif
#endif
#if SITE_ON(4)
                { pg8::Gemm g{(const bf16*)(ws + WS_WVT), HB, D, D, D}; pg8::StaticOrder<1> S; S.init(NVT, MREAL, F.G, (F.wg + 64) % F.G);
                  EpiVT E{VT, SS + (size_t)(3 * l + 1) * MP};
                  pg8::gemm_phase<EpiVT, pg8::StaticOrder<1>, true>(F.lds, g, S, E, F.wave); }
#endif
            }
            SEAM(base + 2);
            #ifndef NO_ATT
            if (IN(base + 3)) { for (int rep = 0; rep < REP_ATT; ++rep) attention_phase(F, l, rep); }
#endif
            SEAM(base + 3);
#if SITE_ON(5)
            if (IN(base + 4)) for (int rep = 0; rep < REP_BR; ++rep) {
                pg8::Gemm g{O, (const bf16*)(ws + WS_WBR), KBR, KBR, 512}; pg8::StaticOrder<3> S; S.init(MREAL, D, F.G, F.wg);
                EpiBr E{Y, (const unsigned char*)GG};
                if (l == 0) { MetaBr Mb{O + (size_t)MREAL * KBR, g.Bt, Y, (const unsigned char*)GG}; meta_gemm<3, MetaBr>(F, Mb, D / 16); }
                pg8::gemm_phase<EpiBr, pg8::StaticOrder<3>, true>(F.lds, g, S, E, F.wave);
            }
#endif
            SEAM(base + 4);
#if SITE_ON(6)
            if (IN(base + 5)) for (int rep = 0; rep < REP_OUT; ++rep) {
                pg8::Gemm g{Y, (const bf16*)(ws + WS_WOUT), D, D, D}; pg8::StaticOrder<1> S; S.init(MREAL, D, F.G, F.wg);
                EpiResidNo8 E{HB, (rep < REP_OUT - 1) ? SS + (size_t)7 * MP : SS + (size_t)(3 * l + 2) * MP, (rep < REP_OUT - 1) ? 0.f : 1.0f};
                if (l == 0) { MetaResid Mr{Y + (size_t)MREAL * D, D, g.Bt, D, HB, E.ssout, E.alpha}; meta_gemm2<1, D / 256, 1, MetaResid>(F, Mr, D / 16, F.wg, F.G); }
                pg8::gemm_phase<EpiResidNo8, pg8::StaticOrder<1>, true>(F.lds, g, S, E, F.wave);
            }
#endif
            SEAM(base + 5);
        }
    }
    if (IN(19)) { for (int rep = 0; rep < REP_FIN; ++rep) final_norm(F); }
#undef IN
#undef SEAM
}

#ifndef MK_SPLIT
#define MK_SPLIT 0
#endif
extern "C" void kernel_launch(void* const* d_in, const int* in_sizes, int n_in, void* d_out, int out_size, void* d_ws, size_t ws_size, hipStream_t stream) {
    static int grid = 0;
    if (grid == 0) {
        if (n_in != 19 || in_sizes[0] != MREAL * D || out_size != MREAL * D || ws_size < WS_END) { fprintf(stderr, "kernel_launch: unexpected shapes (n_in %d in0 %d out %d ws %zu need %zu)\n", n_in, n_in > 0 ? in_sizes[0] : -1, out_size, ws_size, (size_t)WS_END); grid = -1; return; }
        int dev = 0, cus = 0, per_cu = 0;
        if (hipGetDevice(&dev) != hipSuccess || hipDeviceGetAttribute(&cus, hipDeviceAttributeMultiprocessorCount, dev) != hipSuccess) { grid = -1; return; }
        if (hipFuncSetAttribute((const void*)fwd, hipFuncAttributeMaxDynamicSharedMemorySize, LDS_BYTES) != hipSuccess) { fprintf(stderr, "kernel_launch: hipFuncSetAttribute failed\n"); grid = -1; return; }
        if (hipOccupancyMaxActiveBlocksPerMultiprocessor(&per_cu, (const void*)fwd, NWAVES * 64, LDS_BYTES) != hipSuccess || per_cu < 1) fprintf(stderr, "kernel_launch: occupancy query says %d\n", per_cu);
        (void)hipGetLastError();
        grid = cus > 256 ? 256 : cus;
    }
    if (grid < 0) return;
    (void)hipMemsetAsync((char*)d_ws + WS_CTL, 0, CTL_ZERO_BYTES, stream);
    Args a{};
    for (int i = 0; i < 19; ++i) a.in[i] = (const float*)d_in[i];
    a.out = (float*)d_out; a.ws = (unsigned char*)d_ws;
#if MK_SPLIT
#ifndef MAXPH
#define MAXPH N_PHASES
#endif
    if (MAXPH == 0) { a.ph_lo = 0; a.ph_hi = 0; hipLaunchKernelGGL(fwd, dim3(grid), dim3(NWAVES * 64), LDS_BYTES, stream, a); }
    for (int p = 0; p < MAXPH; ++p) { if (p == 18) continue; a.ph_lo = p; a.ph_hi = p + 1; hipLaunchKernelGGL(fwd, dim3(grid), dim3(NWAVES * 64), LDS_BYTES, stream, a); }
#else
    a.ph_lo = 0; a.ph_hi = N_PHASES;
    hipLaunchKernelGGL(fwd, dim3(grid), dim3(NWAVES * 64), LDS_BYTES, stream, a);
#endif
    const hipError_t le = hipPeekAtLastError();
    if (le != hipSuccess) fprintf(stderr, "kernel_launch: launch failed: %s\n", hipGetErrorName(le));
}
```
